# Optimizing an MI355X kernel written in HIP

```python
import math
import jax, jax.numpy as jnp
from jax import lax
import numpy as np

D_MODEL = 1024
BATCH = 2
SEQ = 8192
DEPTH = 2
DEC_BATCH = 8
DEC_SEQ = 2048
PAST_LEN = 128

N_MEM = 256
HEAD_DIM = 64
ATTN_GROUPS = ((128, 1), (512, 4), (2048, 16))
HEADS_PER_GROUP = 4
N_ATTN_HEADS = HEADS_PER_GROUP * len(ATTN_GROUPS)
D_ATTN = N_ATTN_HEADS * HEAD_DIM
D_ATTN_OUT = HEADS_PER_GROUP * HEAD_DIM
QB = 64
NEG = -1e30
LRU_BLOCKS = 12
LRU_BLOCK = 64
D_LRU = LRU_BLOCKS * LRU_BLOCK
CONV_W = 4
LRU_C = 8.0
N_XHEADS = 4
XHEAD_DIM = 128
D_X = N_XHEADS * XHEAD_DIM
N_BRANCH = 3
D_FF = 2816
N_BUCKETS = 32
MAX_DIST = 1024
ALPHA = (2 * DEPTH) ** 0.25
BETA = (8 * DEPTH) ** -0.25
LN_EPS = 1e-5
D_IN = 3 * D_ATTN + 2 * D_LRU + D_X + N_BRANCH * D_MODEL
SPLITS = [D_ATTN, 2 * D_ATTN, 3 * D_ATTN, 3 * D_ATTN + D_LRU, 3 * D_ATTN + 2 * D_LRU,
          3 * D_ATTN + 2 * D_LRU + D_X]

kernel_name = "hybrid_dilated_rglru_memory_encoder"


def layer_norm(x, g, b):
    xf = x.astype(jnp.float32)
    mu = jnp.mean(xf, axis=-1, keepdims=True)
    var = jnp.mean(jnp.square(xf - mu), axis=-1, keepdims=True)
    return ((xf - mu) * lax.rsqrt(var + LN_EPS) * g + b).astype(x.dtype)


def swiglu(x, w_in, w_out):
    gt, up = jnp.split(x @ w_in, 2, axis=-1)
    return (jax.nn.silu(gt) * up) @ w_out


def t5_bucket(rel):
    half = N_BUCKETS // 2
    max_exact = half // 2
    sign = (rel > 0).astype(np.int32) * half
    n = np.abs(rel)
    large = max_exact + (np.log(np.maximum(n, 1) / max_exact) / math.log(MAX_DIST / max_exact)
                         * (half - max_exact)).astype(np.int32)
    large = np.minimum(large, half - 1)
    return sign + np.where(n < max_exact, n, large)


def dilated_group_attention(q, k, v, bias_g, dilation, window):
    B, S, H, Dh = q.shape
    half = window // (2 * dilation)
    n = S // dilation
    nb = -(-n // QB)
    n_pad = nb * QB

    def to_blocks(t):
        t = t.reshape(B, n, dilation, H, Dh).transpose(0, 2, 1, 3, 4)
        t = jnp.pad(t, ((0, 0), (0, 0), (0, n_pad - n), (0, 0), (0, 0)))
        return t.reshape(B, dilation, nb, QB, H, Dh)

    def windows(t):
        tb = jnp.pad(to_blocks(t), ((0, 0), (0, 0), (1, 1), (0, 0), (0, 0), (0, 0)))
        return jnp.concatenate([tb[:, :, :-2], tb[:, :, 1:-1], tb[:, :, 2:]], axis=3)

    qb = to_blocks(q)
    kw = windows(k)
    vw = windows(v).astype(jnp.float32)

    t_idx = np.arange(QB)[:, None]
    u_idx = np.arange(3 * QB)[None, :]
    delta = u_idx - QB - t_idx
    kpos = np.arange(nb)[:, None, None] * QB + u_idx[None] - QB
    valid = (np.abs(delta) <= half)[None] & (kpos >= 0) & (kpos < n)
    bias = jnp.transpose(bias_g[t5_bucket(delta * dilation)], (2, 0, 1)).astype(jnp.float32)

    s = jnp.einsum('bgnqhe,bgnkhe->bgnhqk', qb, kw).astype(jnp.float32) * (HEAD_DIM ** -0.5) + bias
    s = jnp.where(valid[None, None, :, None], s, NEG)
    m = jnp.max(s, axis=-1, keepdims=True)
    p = jnp.exp(s - m)
    l = jnp.sum(p, axis=-1, keepdims=True)
    o = jnp.einsum('bgnhqk,bgnkhe->bgnqhe', p, vw) / jnp.swapaxes(l, 3, 4)
    lse = jnp.swapaxes((m + jnp.log(l))[..., 0], 3, 4)

    o = o.reshape(B, dilation, n_pad, H, Dh)[:, :, :n].transpose(0, 2, 1, 3, 4).reshape(B, S, H, Dh)
    lse = lse.reshape(B, dilation, n_pad, H)[:, :, :n].transpose(0, 2, 1, 3).reshape(B, S, H)
    return o, lse


def centred_dwconv(x, w, b):
    S = x.shape[1]
    lo = (CONV_W - 1) // 2
    xp = jnp.pad(x, ((0, 0), (lo, CONV_W - 1 - lo), (0, 0)))
    return sum(xp[:, j:j + S] * w[j] for j in range(CONV_W)) + b


def rg_lru_scan(x, w_a, b_a, w_x, b_x, lam, reverse):
    B, S, _ = x.shape
    xb = x.reshape(B, S, LRU_BLOCKS, LRU_BLOCK)
    r = jax.nn.sigmoid(jnp.einsum('bshi,hij->bshj', xb, w_a).reshape(B, S, D_LRU) + b_a)
    i = jax.nn.sigmoid(jnp.einsum('bshi,hij->bshj', xb, w_x).reshape(B, S, D_LRU) + b_x)
    log_a = -LRU_C * r.astype(jnp.float32) * jax.nn.softplus(-lam.astype(jnp.float32))
    a = jnp.exp(log_a)
    u = jnp.sqrt(-jnp.expm1(2.0 * log_a)) * (i * x).astype(jnp.float32)

    def combine(c1, c2):
        a1, b1 = c1
        a2, b2 = c2
        return a1 * a2, a2 * b1 + b2

    _, h = lax.associative_scan(combine, (a, u), reverse=reverse, axis=1)
    return h


def memory_attention(q, mem, w_mem_kv):
    B, S, _ = q.shape
    k, v = jnp.split(mem @ w_mem_kv, 2, axis=-1)
    q = q.reshape(B, S, N_XHEADS, XHEAD_DIM)
    k = k.reshape(B, -1, N_XHEADS, XHEAD_DIM)
    v = v.reshape(B, -1, N_XHEADS, XHEAD_DIM)
    s = jnp.einsum('bshe,bmhe->bhsm', q, k).astype(jnp.float32) * (XHEAD_DIM ** -0.5)
    p = jax.nn.softmax(s, axis=-1)
    o = jnp.einsum('bhsm,bmhe->bshe', p, v.astype(jnp.float32))
    return o.reshape(B, S, D_X).astype(q.dtype)


def encoder_layer(x, mem, rel_bias, w_in, b_gate, conv_w, conv_b, lru_wa, lru_ba, lru_wx, lru_bx,
                  lru_lambda, w_mem_kv, w_br_attn, w_br_lru, w_br_mem, w_out, ff_in, ff_out, ln_g, ln_b):
    B, S, _ = x.shape
    x = layer_norm(ALPHA * x + 0.5 * swiglu(x, ff_in[0], ff_out[0]), ln_g[0], ln_b[0])

    q, k, v, xr, gr, qm, gates = jnp.split(x @ w_in, SPLITS, axis=-1)

    q = q.reshape(B, S, N_ATTN_HEADS, HEAD_DIM)
    k = k.reshape(B, S, N_ATTN_HEADS, HEAD_DIM)
    v = v.reshape(B, S, N_ATTN_HEADS, HEAD_DIM)
    outs, lses = [], []
    for gi, (win, dil) in enumerate(ATTN_GROUPS):
        hs = slice(gi * HEADS_PER_GROUP, (gi + 1) * HEADS_PER_GROUP)
        o, lse = dilated_group_attention(q[:, :, hs], k[:, :, hs], v[:, :, hs], rel_bias[:, hs], dil, win)
        outs.append(o)
        lses.append(lse)
    wgt = jax.nn.softmax(jnp.stack(lses, axis=0), axis=0)
    attn = jnp.einsum('gbsh,gbshe->bshe', wgt, jnp.stack(outs, axis=0))
    attn = attn.reshape(B, S, D_ATTN_OUT).astype(x.dtype)

    xc = centred_dwconv(xr, conv_w, conv_b)
    h_fwd = rg_lru_scan(xc, lru_wa[0], lru_ba[0], lru_wx[0], lru_bx[0], lru_lambda[0], reverse=False)
    h_bwd = rg_lru_scan(xc, lru_wa[1], lru_ba[1], lru_wx[1], lru_bx[1], lru_lambda[1], reverse=True)
    rec = jax.nn.gelu(gr) * (h_fwd + h_bwd).astype(x.dtype)

    xm = memory_attention(qm, mem, w_mem_kv)

    g = jax.nn.sigmoid(gates.reshape(B, S, N_BRANCH, D_MODEL) + b_gate)
    merged = (g[:, :, 0] * (attn @ w_br_attn) + g[:, :, 1] * (rec @ w_br_lru)
              + g[:, :, 2] * (xm @ w_br_mem))
    x = layer_norm(ALPHA * x + merged @ w_out, ln_g[1], ln_b[1])

    x = layer_norm(ALPHA * x + 0.5 * swiglu(x, ff_in[1], ff_out[1]), ln_g[2], ln_b[2])
    return x


def encoder_trunk(x, mem, rel_bias, layer_weights):
    for layer in range(DEPTH):
        x = encoder_layer(x, mem, rel_bias, *[w[layer] for w in layer_weights])
    return x


def setup_inputs(seed: int = 0) -> dict:
    key = jax.random.key(seed)
    ks = jax.random.split(key, 24)
    f32 = jnp.float32

    def nrm(k, shape, scale):
        return jax.random.normal(k, shape, f32) * scale

    v_cols = jnp.zeros((D_IN,), bool).at[2 * D_ATTN:3 * D_ATTN].set(True)
    w_in = nrm(ks[5], (DEPTH, D_MODEL, D_IN), D_MODEL ** -0.5) * jnp.where(v_cols, BETA, 1.0)
    kv_scale = jnp.concatenate([jnp.ones((D_X,), f32), jnp.full((D_X,), BETA, f32)])
    a = jax.random.uniform(ks[13], (DEPTH, 2, D_LRU), f32, 0.9, 0.999) ** (1.0 / LRU_C)
    return {
        'x_prompt': nrm(ks[0], (BATCH, SEQ, D_MODEL), 1.0),
        'x_sample': nrm(ks[1], (DEC_BATCH, DEC_SEQ, D_MODEL), 1.0),
        'mem_prompt': nrm(ks[2], (BATCH, N_MEM, D_MODEL), 1.0),
        'mem_sample': nrm(ks[3], (DEC_BATCH, N_MEM, D_MODEL), 1.0),
        'rel_bias': nrm(ks[4], (N_BUCKETS, N_ATTN_HEADS), 0.5),
        'w_in': w_in,
        'b_gate': nrm(ks[6], (DEPTH, N_BRANCH, D_MODEL), 0.1),
        'conv_w': nrm(ks[7], (DEPTH, CONV_W, D_LRU), CONV_W ** -0.5),
        'conv_b': nrm(ks[8], (DEPTH, D_LRU), 0.02),
        'lru_wa': nrm(ks[9], (DEPTH, 2, LRU_BLOCKS, LRU_BLOCK, LRU_BLOCK), LRU_BLOCK ** -0.5),
        'lru_ba': nrm(ks[10], (DEPTH, 2, D_LRU), 0.1),
        'lru_wx': nrm(ks[11], (DEPTH, 2, LRU_BLOCKS, LRU_BLOCK, LRU_BLOCK), LRU_BLOCK ** -0.5),
        'lru_bx': nrm(ks[12], (DEPTH, 2, D_LRU), 0.1),
        'lru_lambda': jnp.log(a) - jnp.log1p(-a),
        'w_mem_kv': nrm(ks[14], (DEPTH, D_MODEL, 2 * D_X), D_MODEL ** -0.5) * kv_scale,
        'w_br_attn': nrm(ks[15], (DEPTH, D_ATTN_OUT, D_MODEL), BETA * D_ATTN_OUT ** -0.5),
        'w_br_lru': nrm(ks[16], (DEPTH, D_LRU, D_MODEL), BETA * D_LRU ** -0.5),
        'w_br_mem': nrm(ks[17], (DEPTH, D_X, D_MODEL), BETA * D_X ** -0.5),
        'w_out': nrm(ks[18], (DEPTH, D_MODEL, D_MODEL), BETA * D_MODEL ** -0.5),
        'ff_in': nrm(ks[19], (DEPTH, 2, D_MODEL, 2 * D_FF), D_MODEL ** -0.5),
        'ff_out': nrm(ks[20], (DEPTH, 2, D_FF, D_MODEL), BETA * D_FF ** -0.5),
        'ln_g': 1.0 + nrm(ks[21], (DEPTH, 3, D_MODEL), 0.02),
        'ln_b': nrm(ks[22], (DEPTH, 3, D_MODEL), 0.02),
    }


def reference(x_prompt, x_sample, mem_prompt, mem_sample, rel_bias, w_in, b_gate, conv_w, conv_b,
              lru_wa, lru_ba, lru_wx, lru_bx, lru_lambda, w_mem_kv, w_br_attn, w_br_lru, w_br_mem,
              w_out, ff_in, ff_out, ln_g, ln_b):
    layer_weights = (w_in, b_gate, conv_w, conv_b, lru_wa, lru_ba, lru_wx, lru_bx, lru_lambda,
                     w_mem_kv, w_br_attn, w_br_lru, w_br_mem, w_out, ff_in, ff_out, ln_g, ln_b)
    y_prompt = encoder_trunk(x_prompt, mem_prompt, rel_bias, layer_weights)
    y_sample = encoder_trunk(x_sample, mem_sample, rel_bias, layer_weights)
    return (y_prompt, y_sample)
```

```cpp
#include <hip/hip_runtime.h>
#include <hip/hip_cooperative_groups.h>
#include <cstdio>
#include <cstdint>
namespace cg = cooperative_groups;

#ifndef MEGA
#define MEGA 0
#endif
#ifndef PH_MASK
#define PH_MASK 0xFFFF
#endif
#define PHON(b) ((PH_MASK >> (b)) & 1)

namespace pg8 {
#define PG8_LAS __attribute__((address_space(3)))
typedef unsigned short bf16_t;
typedef short bf16x8 __attribute__((ext_vector_type(8)));
typedef float f32x4 __attribute__((ext_vector_type(4)));
typedef unsigned u32x4 __attribute__((ext_vector_type(4)));
typedef unsigned u32x2 __attribute__((ext_vector_type(2)));
constexpr int BM = 256, BK = 64, HALF = 128, HTB = HALF * BK * 2, STAGE_BYTES = 8 * HTB, NXCD = 8, WGM = 8;

__host__ __device__ __forceinline__ int lds_byte(int r, int c) { const int st = (r >> 4) * 2 + (c >> 5), rr = r & 15, cc = c & 31, ob = rr * 64 + cc * 2; return st * 1024 + (ob ^ (((ob >> 9) & 1) << 5)); }
__host__ __device__ __forceinline__ void stage_rc(int b, int& R, int& C) { const int st = b / 1024, sb = b % 1024, swz = sb ^ (((sb >> 9) & 1) << 5); R = (st >> 1) * 16 + swz / 64; C = (st & 1) * 32 + (swz % 64) / 2; }
__host__ __device__ __forceinline__ int perm32(int rho) { const int n = rho >> 4, i = rho & 15; return 8 * (i >> 2) + 4 * n + (i & 3); }

struct Unit { int pm, pn; };
struct Gemm { const bf16_t* A; const bf16_t* Bt; int M, N, K; };

struct StaticOrder {
    int nM, nN, nwg, G, c;
    __device__ void init(int M, int N, int G_, int c_) { nM = M / BM; nN = N / BM; nwg = nM * nN; G = G_; c = c_; }
    __device__ bool next(int i, Unit& u) const {
        const long L = (long)i * G + c; if (L >= nwg) return false;
        int wgid = (int)L; { const int q = nwg / NXCD, r = nwg % NXCD, xcd = wgid % NXCD, off = wgid / NXCD; wgid = (xcd < r ? xcd * (q + 1) : r * (q + 1) + (xcd - r) * q) + off; }
        const int nig = WGM * nN, gid = wgid / nig, fm = gid * WGM, gsz = (nM - fm) < WGM ? (nM - fm) : WGM;
        u.pm = fm + ((wgid % nig) % gsz); u.pn = (wgid % nig) / gsz; return true;
    }
    __device__ __forceinline__ void a_ready(const Unit&) const {}
    __device__ __forceinline__ void done(const Unit&) const {}
};
struct BrOrder {
    int G, c, b;
    __device__ bool next(int i, Unit& u) const {
        int cnt = 0;
        for (int L = c; L < 1536; L += G) { const int pn12 = L % 12; if (b < 0 || (pn12 >> 2) == b) { if (cnt == i) { u.pm = L / 12; u.pn = b < 0 ? pn12 : (pn12 & 3); return true; } ++cnt; } }
        return false;
    }
    __device__ __forceinline__ void a_ready(const Unit&) const {}
    __device__ __forceinline__ void done(const Unit&) const {}
};

__device__ __forceinline__ unsigned cvt_pk_bf16(float lo, float hi) { unsigned r; asm volatile("v_cvt_pk_bf16_f32 %0, %1, %2" : "=v"(r) : "v"(lo), "v"(hi)); return r; }
__device__ __forceinline__ float bf_lo(unsigned w) { return __builtin_bit_cast(float, w << 16); }
__device__ __forceinline__ float bf_hi(unsigned w) { return __builtin_bit_cast(float, w & 0xffff0000u); }
__device__ __forceinline__ float fsigmoid(float x) { return __builtin_amdgcn_rcpf(1.f + __expf(-x)); }
__device__ __forceinline__ float fgelu_tanh(float x) { const float u = 0.7978845608028654f * (x + 0.044715f * x * x * x); return x * fsigmoid(2.f * u); }


struct EpiSwiglu {
    static constexpr bool PERM = true, AFTER_DRAIN = false;
    bf16_t* O;
    __device__ __forceinline__ void operator()(const f32x4 (&acc)[2][2][4][2], const Unit& u, int wr, int wc, int fr, int fq) const {
        const int row0 = u.pm * BM + wr * 64 + fr, col0 = (u.pn * BM + wc * 32 + 8 * fq) >> 1;
#pragma unroll
        for (int ai = 0; ai < 2; ++ai)
#pragma unroll
            for (int m = 0; m < 4; ++m) { bf16_t* rowp = O + (size_t)(row0 + ai * HALF + m * 16) * 2816 + col0;
#pragma unroll
                for (int bj = 0; bj < 2; ++bj) { const f32x4 v0 = acc[ai][bj][m][0], v1 = acc[ai][bj][m][1];
                    const float o0 = v0[0] * fsigmoid(v0[0]) * v0[1], o1 = v0[2] * fsigmoid(v0[2]) * v0[3], o2 = v1[0] * fsigmoid(v1[0]) * v1[1], o3 = v1[2] * fsigmoid(v1[2]) * v1[3];
                    u32x2 w; w.x = cvt_pk_bf16(o0, o1); w.y = cvt_pk_bf16(o2, o3);
                    *(u32x2*)(rowp + bj * (HALF / 2)) = w; } }
    }
};
struct EpiResid {
    static constexpr bool PERM = false, AFTER_DRAIN = false;
    const float* base_lo; const float* base_hi; float* out; float alpha, s;
    __device__ __forceinline__ void operator()(const f32x4 (&acc)[2][2][4][2], const Unit& u, int wr, int wc, int fr, int fq) const {
        const int col0 = u.pn * BM + wc * 32 + 4 * fq;
        const float* base = (u.pm < 64) ? base_lo : base_hi;
#pragma unroll
        for (int ai = 0; ai < 2; ++ai)
#pragma unroll
            for (int m = 0; m < 4; ++m) { const size_t off = (size_t)(u.pm * BM + ai * HALF + wr * 64 + m * 16 + fr) * 1024 + col0;
#pragma unroll
                for (int bj = 0; bj < 2; ++bj)
#pragma unroll
                    for (int n = 0; n < 2; ++n) { const f32x4 bs = *(const f32x4*)(base + off + bj * HALF + n * 16);
                        *(f32x4*)(out + off + bj * HALF + n * 16) = bs * alpha + acc[ai][bj][m][n] * s; } }
    }
};
struct EpiBf16 {
    static constexpr bool PERM = true, AFTER_DRAIN = false;
    bf16_t* O; int ldc, coff;
    __device__ __forceinline__ void operator()(const f32x4 (&acc)[2][2][4][2], const Unit& u, int wr, int wc, int fr, int fq) const {
        const int row0 = u.pm * BM + wr * 64 + fr, col0 = coff + u.pn * BM + wc * 32 + 8 * fq;
#pragma unroll
        for (int ai = 0; ai < 2; ++ai)
#pragma unroll
            for (int m = 0; m < 4; ++m) { bf16_t* rowp = O + (size_t)(row0 + ai * HALF + m * 16) * ldc + col0;
#pragma unroll
                for (int bj = 0; bj < 2; ++bj) { const f32x4 v0 = acc[ai][bj][m][0], v1 = acc[ai][bj][m][1];
                    u32x4 w; w.x = cvt_pk_bf16(v0[0], v0[1]); w.y = cvt_pk_bf16(v0[2], v0[3]); w.z = cvt_pk_bf16(v1[0], v1[1]); w.w = cvt_pk_bf16(v1[2], v1[3]);
                    *(u32x4*)(rowp + bj * HALF) = w; } }
    }
};
struct EpiWin {
    static constexpr bool PERM = true, AFTER_DRAIN = false;
    bf16_t* QKVX; bf16_t* GR; bf16_t* QM;
    __device__ __forceinline__ void operator()(const f32x4 (&acc)[2][2][4][2], const Unit& u, int wr, int wc, int fr, int fq) const {
        const int row0 = u.pm * BM + wr * 64 + fr; const int pn = u.pn;
        bf16_t* base; int ldc, colt; float sc = 1.f; bool gel = false;
        if (pn < 12) { base = QKVX; ldc = 3072; colt = pn * BM; if (pn < 3) sc = 0.125f; }
        else if (pn < 15) { base = GR; ldc = 768; colt = (pn - 12) * BM; gel = true; }
        else { base = QM; ldc = 512; colt = (pn - 15) * BM; sc = 0.08838834764831845f; }
        const int col0 = colt + wc * 32 + 8 * fq;
#pragma unroll
        for (int ai = 0; ai < 2; ++ai)
#pragma unroll
            for (int m = 0; m < 4; ++m) { bf16_t* rowp = base + (size_t)(row0 + ai * HALF + m * 16) * ldc + col0;
#pragma unroll
                for (int bj = 0; bj < 2; ++bj) { f32x4 v0 = acc[ai][bj][m][0], v1 = acc[ai][bj][m][1];
                    if (gel) {
#pragma unroll
                        for (int e = 0; e < 4; ++e) { v0[e] = fgelu_tanh(v0[e]); v1[e] = fgelu_tanh(v1[e]); } }
                    v0 = v0 * sc; v1 = v1 * sc;
                    u32x4 w; w.x = cvt_pk_bf16(v0[0], v0[1]); w.y = cvt_pk_bf16(v0[2], v0[3]); w.z = cvt_pk_bf16(v1[0], v1[1]); w.w = cvt_pk_bf16(v1[2], v1[3]);
                    *(u32x4*)(rowp + bj * HALF) = w; } }
    }
};
struct EpiGate {
    static constexpr bool PERM = true, AFTER_DRAIN = false;
    bf16_t* G; const float* bg;
    __device__ __forceinline__ void operator()(const f32x4 (&acc)[2][2][4][2], const Unit& u, int wr, int wc, int fr, int fq) const {
        const int row0 = u.pm * BM + wr * 64 + fr, col0 = u.pn * BM + wc * 32 + 8 * fq;
#pragma unroll
        for (int bj = 0; bj < 2; ++bj) { const f32x4 b0 = *(const f32x4*)(bg + col0 + bj * HALF), b1 = *(const f32x4*)(bg + col0 + bj * HALF + 4);
#pragma unroll
            for (int ai = 0; ai < 2; ++ai)
#pragma unroll
                for (int m = 0; m < 4; ++m) { bf16_t* p = G + (size_t)(row0 + ai * HALF + m * 16) * 3072 + col0 + bj * HALF;
                    const u32x4 pv = *(const u32x4*)p; const f32x4 v0 = acc[ai][bj][m][0] + b0, v1 = acc[ai][bj][m][1] + b1;
                    u32x4 w;
                    w.x = cvt_pk_bf16(fsigmoid(v0[0]) * bf_lo(pv.x), fsigmoid(v0[1]) * bf_hi(pv.x));
                    w.y = cvt_pk_bf16(fsigmoid(v0[2]) * bf_lo(pv.y), fsigmoid(v0[3]) * bf_hi(pv.y));
                    w.z = cvt_pk_bf16(fsigmoid(v1[0]) * bf_lo(pv.z), fsigmoid(v1[1]) * bf_hi(pv.z));
                    w.w = cvt_pk_bf16(fsigmoid(v1[2]) * bf_lo(pv.w), fsigmoid(v1[3]) * bf_hi(pv.w));
                    *(u32x4*)p = w; } }
    }
};

template <class Epi, class Sched, bool ALIGN_EPI = false, bool SP2 = false>
__device__ __forceinline__ void gemm_phase(PG8_LAS unsigned char* lds, const Gemm g, const Sched& S, const Epi& E) {
    int tid_ = threadIdx.x; asm volatile("" : "+v"(tid_));
    const int tid = tid_, wid = __builtin_amdgcn_readfirstlane(tid >> 6), lane = tid & 63, wr = wid >> 2, wc = wid & 3, fr = lane & 15, fq = lane >> 4;
    const int K = g.K, nt = K / BK;
    unsigned voffA[2], voffB[2];
#pragma unroll
    for (int i = 0; i < 2; ++i) { int R, C; stage_rc(tid * 16 + i * 8192, R, C); const int Rb = Epi::PERM ? ((R & ~31) + perm32(R & 31)) : R;
        voffA[i] = (unsigned)(R * K + C) * 2u; voffB[i] = (unsigned)(Rb * K + C) * 2u; }
    const size_t kstep = (size_t)(BK * 2);
    const size_t hstep = (size_t)HALF * K * 2;
    const size_t tstep = 2 * hstep;
    const unsigned ldsw = (unsigned)wid * 1024u;
    const int aoff = lds_byte(wr * 64 + fr, fq * 8), boff = lds_byte(wc * 32 + fr, fq * 8);
#define PG8_SA(b, h) (((b) * 2 + (h)) * HTB)
#define PG8_SB(b, h) ((4 + (b) * 2 + (h)) * HTB)
#define PG8_STAGE(bufoff, gbase, voff) do { _Pragma("unroll") for (int _i = 0; _i < 2; ++_i) \
        __builtin_amdgcn_global_load_lds((const unsigned*)((const char*)(gbase) + (voff)[_i]), (PG8_LAS unsigned*)(lds + (bufoff) + ldsw + _i * 8192), 16, 0, 0); } while (0)
#define PG8_LDA(dst, b, h) do { _Pragma("unroll") for (int m = 0; m < 4; ++m) _Pragma("unroll") for (int k = 0; k < 2; ++k) dst[m][k] = *(const PG8_LAS bf16x8*)(lds + PG8_SA(b, h) + aoff + m * 2048 + k * 1024); } while (0)
#define PG8_LDB(dst, b, h) do { _Pragma("unroll") for (int n = 0; n < 2; ++n) _Pragma("unroll") for (int k = 0; k < 2; ++k) dst[n][k] = *(const PG8_LAS bf16x8*)(lds + PG8_SB(b, h) + boff + n * 2048 + k * 1024); } while (0)
#define PG8_MMA(ai, bj, At, Bt) do { __builtin_amdgcn_s_setprio(1); _Pragma("unroll") for (int m = 0; m < 4; ++m) _Pragma("unroll") for (int n = 0; n < 2; ++n) _Pragma("unroll") for (int k = 0; k < 2; ++k) \
        acc[ai][bj][m][n] = __builtin_amdgcn_mfma_f32_16x16x32_bf16(Bt[n][k], At[m][k], acc[ai][bj][m][n], 0, 0, 0); __builtin_amdgcn_s_setprio(0); } while (0)
#define PG8_WAIT_V(n) asm volatile("s_waitcnt vmcnt(" #n ")" ::: "memory")
#define PG8_WAIT_L(n) asm volatile("s_waitcnt lgkmcnt(" #n ")" ::: "memory")
#define PG8_BAR __builtin_amdgcn_s_barrier()
#define PG8_SCHED __builtin_amdgcn_sched_barrier(0)
    Unit cur, nxt; int ui = 0;
    if (!S.next(0, cur)) return;
    f32x4 acc[2][2][4][2];
#pragma unroll
    for (int a = 0; a < 2; ++a)
#pragma unroll
        for (int b = 0; b < 2; ++b)
#pragma unroll
            for (int m = 0; m < 4; ++m)
#pragma unroll
                for (int n = 0; n < 2; ++n) acc[a][b][m][n] = (f32x4){0.f, 0.f, 0.f, 0.f};
    bf16x8 At[4][2], B0[2][2], B1[2][2];
    const char* cA = (const char*)g.A + (size_t)cur.pm * tstep; const char* cB = (const char*)g.Bt + (size_t)cur.pn * tstep;
    S.a_ready(cur);
    if constexpr (SP2) {
        PG8_STAGE(PG8_SB(0, 0), cB, voffB); PG8_STAGE(PG8_SB(0, 1), cB + hstep, voffB); PG8_STAGE(PG8_SA(0, 0), cA, voffA); PG8_STAGE(PG8_SA(0, 1), cA + hstep, voffA);
        if (wr == 1) PG8_BAR;
        PG8_WAIT_V(2); PG8_BAR;
        PG8_STAGE(PG8_SB(1, 0), cB + kstep, voffB); PG8_STAGE(PG8_SA(1, 0), cA + kstep, voffA); PG8_STAGE(PG8_SB(1, 1), cB + hstep + kstep, voffB);
        PG8_WAIT_V(6); PG8_BAR;
    } else {
        PG8_STAGE(PG8_SB(0, 0), cB, voffB); PG8_STAGE(PG8_SA(0, 0), cA, voffA); PG8_STAGE(PG8_SB(0, 1), cB + hstep, voffB); PG8_STAGE(PG8_SA(0, 1), cA + hstep, voffA);
        if (wr == 1) PG8_BAR;
        PG8_WAIT_V(4); PG8_BAR;
        PG8_STAGE(PG8_SB(1, 0), cB + kstep, voffB); PG8_STAGE(PG8_SA(1, 0), cA + kstep, voffA); PG8_STAGE(PG8_SB(1, 1), cB + hstep + kstep, voffB);
        PG8_WAIT_V(6); PG8_BAR;
    }
    for (;;) {
        const bool has_next = S.next(ui + 1, nxt);
        const char* nA = has_next ? (const char*)g.A + (size_t)nxt.pm * tstep : cA; const char* nB = has_next ? (const char*)g.Bt + (size_t)nxt.pn * tstep : cB;
        for (int t = 0; t < nt; t += 2) {
            const bool last = (t == nt - 2);
            const char* a1 = cA + (size_t)(t + 1) * kstep;
            const char* a2 = last ? nA : cA + (size_t)(t + 2) * kstep; const char* b2 = last ? nB : cB + (size_t)(t + 2) * kstep;
            const char* a3 = a2 + kstep; const char* b3 = b2 + kstep;
            if (last && has_next) S.a_ready(nxt);
            if constexpr (SP2) {
            PG8_LDB(B0, 0, 0); PG8_LDB(B1, 0, 1); PG8_SCHED; PG8_LDA(At, 0, 0); PG8_STAGE(PG8_SA(1, 1), a1 + hstep, voffA);
            PG8_WAIT_V(8); PG8_WAIT_L(0); PG8_BAR; PG8_MMA(0, 0, At, B0); PG8_MMA(0, 1, At, B1); PG8_BAR; PG8_SCHED;
            PG8_LDA(At, 0, 1); PG8_STAGE(PG8_SB(0, 0), b2, voffB); PG8_STAGE(PG8_SB(0, 1), b2 + hstep, voffB); PG8_STAGE(PG8_SA(0, 0), a2, voffA);
            PG8_WAIT_V(8); PG8_WAIT_L(0); PG8_BAR; PG8_MMA(1, 0, At, B0); PG8_MMA(1, 1, At, B1); PG8_BAR; PG8_SCHED;
            PG8_LDB(B0, 1, 0); PG8_LDB(B1, 1, 1); PG8_SCHED; PG8_LDA(At, 1, 0); PG8_STAGE(PG8_SA(0, 1), a2 + hstep, voffA);
            PG8_WAIT_V(8); PG8_WAIT_L(0); PG8_BAR; PG8_MMA(0, 0, At, B0); PG8_MMA(0, 1, At, B1); PG8_BAR; PG8_SCHED;
            PG8_LDA(At, 1, 1); PG8_STAGE(PG8_SB(1, 0), b3, voffB); PG8_STAGE(PG8_SB(1, 1), b3 + hstep, voffB); PG8_STAGE(PG8_SA(1, 0), a3, voffA);
            PG8_WAIT_V(8); PG8_WAIT_L(0); PG8_BAR; PG8_MMA(1, 0, At, B0); PG8_MMA(1, 1, At, B1); PG8_BAR; PG8_SCHED;
            } else {
            PG8_LDB(B0, 0, 0); PG8_SCHED; PG8_LDA(At, 0, 0); PG8_STAGE(PG8_SA(1, 1), a1 + hstep, voffA);
            PG8_WAIT_L(8); PG8_BAR; PG8_WAIT_L(0); PG8_MMA(0, 0, At, B0); PG8_BAR; PG8_SCHED;
            PG8_LDB(B1, 0, 1); PG8_STAGE(PG8_SB(0, 0), b2, voffB);
            PG8_BAR; PG8_WAIT_L(0); PG8_MMA(0, 1, At, B1); PG8_BAR;
            PG8_LDA(At, 0, 1); PG8_STAGE(PG8_SA(0, 0), a2, voffA);
            PG8_BAR; PG8_WAIT_L(0); PG8_MMA(1, 0, At, B0); PG8_BAR; PG8_SCHED;
            PG8_STAGE(PG8_SB(0, 1), b2 + hstep, voffB);
            PG8_WAIT_V(6); PG8_BAR; PG8_MMA(1, 1, At, B1); PG8_BAR;
            PG8_LDB(B0, 1, 0); PG8_SCHED; PG8_LDA(At, 1, 0); PG8_STAGE(PG8_SA(0, 1), a2 + hstep, voffA);
            PG8_WAIT_L(8); PG8_BAR; PG8_WAIT_L(0); PG8_MMA(0, 0, At, B0); PG8_BAR; PG8_SCHED;
            PG8_LDB(B1, 1, 1); PG8_STAGE(PG8_SB(1, 0), b3, voffB);
            PG8_BAR; PG8_WAIT_L(0); PG8_MMA(0, 1, At, B1); PG8_BAR;
            PG8_LDA(At, 1, 1); PG8_STAGE(PG8_SA(1, 0), a3, voffA);
            PG8_BAR; PG8_WAIT_L(0); PG8_MMA(1, 0, At, B0); PG8_BAR; PG8_SCHED;
            PG8_STAGE(PG8_SB(1, 1), b3 + hstep, voffB);
            PG8_WAIT_V(6); PG8_BAR; PG8_MMA(1, 1, At, B1); PG8_BAR;
            }
        }
        if constexpr (ALIGN_EPI) { if (wr == 0) PG8_BAR; }
        if constexpr (!Epi::AFTER_DRAIN) { E(acc, cur, wr, wc, fr, fq); S.done(cur); }
        if (!has_next) break;
#pragma unroll
        for (int a = 0; a < 2; ++a)
#pragma unroll
            for (int b = 0; b < 2; ++b)
#pragma unroll
                for (int m = 0; m < 4; ++m)
#pragma unroll
                    for (int n = 0; n < 2; ++n) acc[a][b][m][n] = (f32x4){0.f, 0.f, 0.f, 0.f};
        cur = nxt; cA = nA; cB = nB; ++ui;
        if constexpr (ALIGN_EPI) { if (wr == 1) PG8_BAR; }
    }
    PG8_WAIT_V(0);
    if constexpr (!ALIGN_EPI) { if (wr == 0) PG8_BAR; }
    PG8_BAR;
#undef PG8_SA
#undef PG8_SB
#undef PG8_STAGE
#undef PG8_LDA
#undef PG8_LDB
#undef PG8_MMA
#undef PG8_WAIT_V
#undef PG8_WAIT_L
#undef PG8_BAR
#undef PG8_SCHED
}
}

#define LAS __attribute__((address_space(3)))
typedef unsigned short bf16;
typedef unsigned v4u __attribute__((ext_vector_type(4)));
typedef float f32x4 __attribute__((ext_vector_type(4)));
typedef float f32x2 __attribute__((ext_vector_type(2)));
typedef short bf16x8 __attribute__((ext_vector_type(8)));
constexpr int T = 32768, D = 1024, DFF = 2816, NCHUNK = T / 64, DIN = 7424;
constexpr int NWAVES = 8, NTHR = 512;
constexpr float ALPHA = 1.4142135623730951f, LN_EPS = 1e-5f;
constexpr int LDS_BYTES = 147456;
constexpr size_t MiB = 1u << 20;
constexpr size_t WS_WT = 1 * MiB, WS_XB = 61 * MiB, WS_MEMB = 125 * MiB, WS_MEMKV = 130 * MiB, WS_CAR = 135 * MiB, WS_CIN = 141 * MiB, WS_LSE = 144 * MiB,
                 WS_QKVX = 146 * MiB, WS_ACT = 146 * MiB, WS_GR = 338 * MiB, WS_QM = 386 * MiB, WS_ATTN = 418 * MiB, WS_END = 434 * MiB;
constexpr size_t WT_FFIN0 = 0, WT_FFIN1 = 5767168, WT_FFOUT0 = 11534336, WT_FFOUT1 = 14417920, WT_WIN = 17301504, WT_MEMKV = 24903680,
                 WT_BRA = 25952256, WT_BRL = 26214400, WT_BRM = 27000832, WT_WOUT = 27525120, WT_LRU = 30670848, WT_END = 30867456;
static_assert(WT_END * 2 <= 60 * MiB, "weights fit");

struct Params {
    const float* x_prompt; const float* x_sample; const float* mem_prompt; const float* mem_sample; const float* rel_bias;
    const float* w_in; const float* b_gate; const float* conv_w; const float* conv_b; const float* lru_wa; const float* lru_ba;
    const float* lru_wx; const float* lru_bx; const float* lru_lambda; const float* w_mem_kv; const float* w_br_attn; const float* w_br_lru;
    const float* w_br_mem; const float* w_out; const float* ff_in; const float* ff_out; const float* ln_g; const float* ln_b;
    float* out; unsigned char* ws; int ph_lo, ph_hi;
};

__device__ __forceinline__ unsigned f2bf(float f) { unsigned u = __builtin_bit_cast(unsigned, f); return (u + 0x7fffu + ((u >> 16) & 1u)) >> 16; }
__device__ __forceinline__ unsigned pk2(float lo, float hi) { return f2bf(lo) | (f2bf(hi) << 16); }
__device__ __forceinline__ float bflo(unsigned w) { return __builtin_bit_cast(float, w << 16); }
__device__ __forceinline__ float bfhi(unsigned w) { return __builtin_bit_cast(float, w & 0xffff0000u); }
__device__ __forceinline__ float wave_sum(float v) {
#pragma unroll
    for (int o = 1; o < 64; o <<= 1) v += __shfl_xor(v, o);
    return v;
}
#define LDS_WAIT() asm volatile("s_waitcnt lgkmcnt(0)" ::: "memory")

__device__ __forceinline__ void cvt_item(const float* W, int ldw, bf16* WT, int pitch, int rmul, int k0, int n0, LAS float* scr, int lane) {
#pragma unroll 8
    for (int i = 0; i < 32; ++i) { const int kk = 2 * i + (lane >> 5); scr[kk * 33 + (lane & 31)] = W[(size_t)(k0 + kk) * ldw + n0 + (lane & 31)]; }
    LDS_WAIT(); asm volatile("" ::: "memory");
    const int c = lane & 7;
#pragma unroll
    for (int j = 0; j < 4; ++j) { const int n = (lane >> 3) + 8 * j; const LAS float* s = scr + (8 * c) * 33 + n;
        v4u o; o.x = pk2(s[0 * 33], s[1 * 33]); o.y = pk2(s[2 * 33], s[3 * 33]); o.z = pk2(s[4 * 33], s[5 * 33]); o.w = pk2(s[6 * 33], s[7 * 33]);
        *(v4u*)(WT + (size_t)(rmul * (n0 + n)) * pitch + k0 + 8 * c) = o; }
    LDS_WAIT(); asm volatile("" ::: "memory");
}
constexpr int CVT_ITEMS = 15072;
__device__ __forceinline__ void cvt_weights(const Params& p, int L, LAS unsigned char* lds, int gw, int ngw, int wave, int lane) {
    LAS float* scr = (LAS float*)(lds + wave * 16384);
    bf16* WT = (bf16*)(p.ws + WS_WT);
    for (int it = gw; it < CVT_ITEMS; it += ngw) {
        int r = it; const float* src; int ldw, K, Nc, pitch, rmul = 1; bf16* dst;
        if (r < 5632) { const int j = r / 1408; r -= j * 1408; const int f = j >> 1, up = j & 1;
            src = p.ff_in + (size_t)(L * 2 + f) * 1024 * 5632 + up * 2816; ldw = 5632; K = 1024; Nc = 2816; dst = WT + (f ? WT_FFIN1 : WT_FFIN0) + (size_t)up * 1024; pitch = 1024; rmul = 2; }
        else if ((r -= 5632) < 2816) { const int f = r / 1408; r -= f * 1408;
            src = p.ff_out + (size_t)(L * 2 + f) * 2816 * 1024; ldw = 1024; K = 2816; Nc = 1024; dst = WT + (f ? WT_FFOUT1 : WT_FFOUT0); pitch = 2816; }
        else if ((r -= 2816) < 3712) { src = p.w_in + (size_t)L * 1024 * DIN; ldw = DIN; K = 1024; Nc = DIN; dst = WT + WT_WIN; pitch = 1024; }
        else if ((r -= 3712) < 512) { src = p.w_mem_kv + (size_t)L * 1024 * 1024; ldw = 1024; K = 1024; Nc = 1024; dst = WT + WT_MEMKV; pitch = 1024; }
        else if ((r -= 512) < 128) { src = p.w_br_attn + (size_t)L * 256 * 1024; ldw = 1024; K = 256; Nc = 1024; dst = WT + WT_BRA; pitch = 256; }
        else if ((r -= 128) < 384) { src = p.w_br_lru + (size_t)L * 768 * 1024; ldw = 1024; K = 768; Nc = 1024; dst = WT + WT_BRL; pitch = 768; }
        else if ((r -= 384) < 256) { src = p.w_br_mem + (size_t)L * 512 * 1024; ldw = 1024; K = 512; Nc = 1024; dst = WT + WT_BRM; pitch = 512; }
        else if ((r -= 256) < 1536) { const int j = r / 512; r -= j * 512; src = p.w_out + (size_t)L * 1024 * 1024; ldw = 1024; K = 1024; Nc = 1024; dst = WT + WT_WOUT + j * 1024; pitch = 3072; }
        else { r -= 1536; const int mi = r >> 1; r &= 1; const int g = mi / 24, dir = (mi % 24) / 12, blk = mi % 12;
            src = (g ? p.lru_wx : p.lru_wa) + (size_t)((L * 2 + dir) * 12 + blk) * 4096; ldw = 64; K = 64; Nc = 64; dst = WT + WT_LRU + (size_t)(((dir * 12 + blk) * 2 + g) * 64) * 64; pitch = 64; }
        const int nblk = Nc / 32, kb = r / nblk, nb = r % nblk;
        cvt_item(src, ldw, dst, pitch, rmul, 64 * kb, 32 * nb, scr, lane);
    }
}
__device__ __forceinline__ void cvt_row(const float* xrow, bf16* orow, int lane) {
    const f32x4* xr = (const f32x4*)xrow + lane; unsigned long long* o8 = (unsigned long long*)orow + lane;
#pragma unroll
    for (int j = 0; j < 4; ++j) { const f32x4 v = xr[64 * j]; o8[64 * j] = (unsigned long long)pk2(v.x, v.y) | ((unsigned long long)pk2(v.z, v.w) << 32); }
}
__device__ __forceinline__ void ln_row(float* zrow, bf16* orow, const float* g, const float* b, int lane, bool write_bf) {
    f32x4* xr = (f32x4*)zrow + lane;
    f32x4 v[4]; float s = 0.f;
#pragma unroll
    for (int j = 0; j < 4; ++j) { v[j] = xr[64 * j]; s += (v[j].x + v[j].y) + (v[j].z + v[j].w); }
    const float mean = wave_sum(s) * (1.f / D); float s2 = 0.f;
#pragma unroll
    for (int j = 0; j < 4; ++j) { v[j] = v[j] - mean; s2 += (v[j].x * v[j].x + v[j].y * v[j].y) + (v[j].z * v[j].z + v[j].w * v[j].w); }
    const float rstd = 1.f / sqrtf(wave_sum(s2) * (1.f / D) + LN_EPS);
    unsigned long long* o8 = (unsigned long long*)orow + lane;
#pragma unroll
    for (int j = 0; j < 4; ++j) { const f32x4 gg = ((const f32x4*)g)[lane + 64 * j], bb = ((const f32x4*)b)[lane + 64 * j];
        const f32x4 y = v[j] * rstd * gg + bb; xr[64 * j] = y;
        if (write_bf) o8[64 * j] = (unsigned long long)pk2(y.x, y.y) | ((unsigned long long)pk2(y.z, y.w) << 32); }
}

__device__ __forceinline__ int t5_bucket(int rel) {
    const int n = rel < 0 ? -rel : rel;
    int b = n < 8 ? n : 8 + (n >= 15) + (n >= 27) + (n >= 50) + (n >= 91) + (n >= 166) + (n >= 305) + (n >= 559);
    return b + (rel > 0 ? 16 : 0);
}

#define MFMA16(a, b, c) __builtin_amdgcn_mfma_f32_16x16x32_bf16(a, b, c, 0, 0, 0)

constexpr int AT_KS = 0, AT_VT = 27648, AT_BIAS = 27648 + 25600, AT_HALF = 55296;
__device__ __forceinline__ void attn_pair(const Params& p, LAS unsigned char* lds, int item, const int tid) {
    const int hw = tid >> 8, t2 = tid & 255, lane = tid & 63, wq = (tid >> 6) & 3, fr = lane & 15, fq = lane >> 4;
    LAS unsigned char* L = lds + hw * AT_HALF;
    bf16* QKVX = (bf16*)(p.ws + WS_QKVX); float* LSE = (float*)(p.ws + WS_LSE);
    const int hh = item % 12, tq = item / 12;
    int m0, S, lt;
    if (tq < 256) { m0 = (tq >> 7) * 8192; lt = tq & 127; S = 8192; } else { const int t = tq - 256; m0 = 16384 + (t >> 5) * 2048; lt = t & 31; S = 2048; }
    const int g = hh >> 2, dsh = 2 * g, d = 1 << dsh, n = S >> dsh, nblk = n >> 6, r = lt / nblk, nb = lt % nblk;
#pragma unroll
    for (int k = 0; k < 6; ++k) {
        { const int c = k * 256 + t2, key = c >> 3, d8 = c & 7, jk = nb * 64 - 64 + key; v4u v = (v4u){0u, 0u, 0u, 0u};
          if (jk >= 0 && jk < n) v = *(const v4u*)(QKVX + (size_t)(m0 + jk * d + r) * 3072 + 768 + hh * 64 + d8 * 8);
          *(LAS v4u*)(L + AT_KS + key * 144 + d8 * 16) = v; }
        { const int c = k * 256 + t2, key = c % 192, d8 = c / 192, jk = nb * 64 - 64 + key; v4u v = (v4u){0u, 0u, 0u, 0u};
          if (jk >= 0 && jk < n) v = *(const v4u*)(QKVX + (size_t)(m0 + jk * d + r) * 3072 + 1536 + hh * 64 + d8 * 8);
          LAS bf16* vt = (LAS bf16*)(L + AT_VT) + (d8 * 8) * 200 + key;
          vt[0 * 200] = (bf16)(v.x & 0xffffu); vt[1 * 200] = (bf16)(v.x >> 16); vt[2 * 200] = (bf16)(v.y & 0xffffu); vt[3 * 200] = (bf16)(v.y >> 16);
          vt[4 * 200] = (bf16)(v.z & 0xffffu); vt[5 * 200] = (bf16)(v.z >> 16); vt[6 * 200] = (bf16)(v.w & 0xffffu); vt[7 * 200] = (bf16)(v.w >> 16); }
    }
    if (t2 < 129) ((LAS float*)(L + AT_BIAS))[t2] = p.rel_bias[t5_bucket((t2 - 64) * d) * 12 + hh];
    bf16x8 qa[2];
    { const int i = 16 * wq + fr; const bf16* qp = QKVX + (size_t)(m0 + (nb * 64 + i) * d + r) * 3072 + hh * 64 + 8 * fq;
      qa[0] = *(const bf16x8*)qp; qa[1] = *(const bf16x8*)(qp + 32); }
    __syncthreads();
    f32x4 sc[12];
#pragma unroll
    for (int ct = 0; ct < 12; ++ct) { sc[ct] = (f32x4){0.f, 0.f, 0.f, 0.f};
#pragma unroll
        for (int ks = 0; ks < 2; ++ks) { const bf16x8 kb = *(const LAS bf16x8*)(L + AT_KS + (16 * ct + fr) * 144 + (32 * ks + 8 * fq) * 2); sc[ct] = MFMA16(qa[ks], kb, sc[ct]); } }
    float mx[4] = {-3e38f, -3e38f, -3e38f, -3e38f};
#pragma unroll
    for (int ct = 0; ct < 12; ++ct) { const int u = 16 * ct + fr, jk = nb * 64 - 64 + u; const bool kv = (jk >= 0 && jk < n);
#pragma unroll
        for (int e = 0; e < 4; ++e) { const int i = 16 * wq + 4 * fq + e, dl = u - 64 - i; const bool ok = kv && dl >= -64 && dl <= 64;
            const float b = ((const LAS float*)(L + AT_BIAS))[ok ? dl + 64 : 0];
            const float s = ok ? sc[ct][e] + b : -1e30f; sc[ct][e] = s; mx[e] = fmaxf(mx[e], s); } }
    float sm[4];
#pragma unroll
    for (int e = 0; e < 4; ++e) {
#pragma unroll
        for (int o = 1; o < 16; o <<= 1) mx[e] = fmaxf(mx[e], __shfl_xor(mx[e], o));
        sm[e] = 0.f; }
#pragma unroll
    for (int ct = 0; ct < 12; ++ct)
#pragma unroll
        for (int e = 0; e < 4; ++e) { const float pv = __expf(sc[ct][e] - mx[e]); sc[ct][e] = pv; sm[e] += pv; }
#pragma unroll
    for (int e = 0; e < 4; ++e) {
#pragma unroll
        for (int o = 1; o < 16; o <<= 1) sm[e] += __shfl_xor(sm[e], o); }
    __syncthreads();
    LAS bf16* Pw = (LAS bf16*)(L + AT_KS + wq * 6400);
#pragma unroll
    for (int ct = 0; ct < 12; ++ct)
#pragma unroll
        for (int e = 0; e < 4; ++e) Pw[(4 * fq + e) * 200 + 16 * ct + fr] = (bf16)f2bf(sc[ct][e]);
    __syncthreads();
    f32x4 oc[4];
#pragma unroll
    for (int dt = 0; dt < 4; ++dt) oc[dt] = (f32x4){0.f, 0.f, 0.f, 0.f};
#pragma unroll
    for (int ks = 0; ks < 6; ++ks) { const bf16x8 pa = *(const LAS bf16x8*)((LAS unsigned char*)Pw + fr * 400 + (32 * ks + 8 * fq) * 2);
#pragma unroll
        for (int dt = 0; dt < 4; ++dt) { const bf16x8 vb = *(const LAS bf16x8*)(L + AT_VT + (16 * dt + fr) * 400 + (32 * ks + 8 * fq) * 2); oc[dt] = MFMA16(pa, vb, oc[dt]); } }
#pragma unroll
    for (int e = 0; e < 4; ++e) { const int i = 16 * wq + 4 * fq + e; const size_t m = (size_t)(m0 + (nb * 64 + i) * d + r); const float inv = 1.f / sm[e];
#pragma unroll
        for (int dt = 0; dt < 4; ++dt) QKVX[m * 3072 + hh * 64 + 16 * dt + fr] = (bf16)f2bf(oc[dt][e] * inv);
        if (fr == 0) LSE[m * 12 + hh] = mx[e] + __logf(sm[e]); }
    __syncthreads();
}

constexpr int MA_KS = 0, MA_P = 69632;
__device__ __forceinline__ void memattn_item(const Params& p, LAS unsigned char* lds, int item, const int tid) {
    const int lane = tid & 63, w = tid >> 6, fr = lane & 15, fq = lane >> 4;
    bf16* QM = (bf16*)(p.ws + WS_QM); const bf16* MKV = (const bf16*)(p.ws + WS_MEMKV);
    int bi, h, m0;
    if (item < 512) { bi = item >> 8; const int rem = item & 255; h = rem >> 6; m0 = bi * 8192 + (rem & 63) * 128; }
    else { const int it = item - 512; bi = 2 + (it >> 6); const int rem = it & 63; h = rem >> 4; m0 = 16384 + (bi - 2) * 2048 + (rem & 15) * 128; }
    const bf16* kbase = MKV + (size_t)(bi * 256) * 1024 + h * 128;
#pragma unroll
    for (int k = 0; k < 8; ++k) { const int c = k * 512 + tid, key = c >> 4, d8 = c & 15;
        *(LAS v4u*)(lds + MA_KS + key * 272 + d8 * 16) = *(const v4u*)(kbase + (size_t)key * 1024 + d8 * 8); }
    bf16x8 qa[4];
    { const bf16* qp = QM + (size_t)(m0 + 16 * w + fr) * 512 + h * 128 + 8 * fq;
#pragma unroll
      for (int ks = 0; ks < 4; ++ks) qa[ks] = *(const bf16x8*)(qp + 32 * ks); }
    __syncthreads();
    f32x4 sc[16];
#pragma unroll
    for (int ct = 0; ct < 16; ++ct) { sc[ct] = (f32x4){0.f, 0.f, 0.f, 0.f};
#pragma unroll
        for (int ks = 0; ks < 4; ++ks) { const bf16x8 kb = *(const LAS bf16x8*)(lds + MA_KS + (16 * ct + fr) * 272 + (32 * ks + 8 * fq) * 2); sc[ct] = MFMA16(qa[ks], kb, sc[ct]); } }
    float mx[4] = {-3e38f, -3e38f, -3e38f, -3e38f}, sm[4] = {0.f, 0.f, 0.f, 0.f};
#pragma unroll
    for (int ct = 0; ct < 16; ++ct)
#pragma unroll
        for (int e = 0; e < 4; ++e) mx[e] = fmaxf(mx[e], sc[ct][e]);
#pragma unroll
    for (int e = 0; e < 4; ++e) {
#pragma unroll
        for (int o = 1; o < 16; o <<= 1) mx[e] = fmaxf(mx[e], __shfl_xor(mx[e], o)); }
#pragma unroll
    for (int ct = 0; ct < 16; ++ct)
#pragma unroll
        for (int e = 0; e < 4; ++e) { const float pv = __expf(sc[ct][e] - mx[e]); sc[ct][e] = pv; sm[e] += pv; }
#pragma unroll
    for (int e = 0; e < 4; ++e) {
#pragma unroll
        for (int o = 1; o < 16; o <<= 1) sm[e] += __shfl_xor(sm[e], o); }
    LAS bf16* Pw = (LAS bf16*)(lds + MA_P + w * 8448);
#pragma unroll
    for (int ct = 0; ct < 16; ++ct)
#pragma unroll
        for (int e = 0; e < 4; ++e) Pw[(4 * fq + e) * 264 + 16 * ct + fr] = (bf16)f2bf(sc[ct][e]);
    __syncthreads();
    const bf16* vbase = kbase + 512;
#pragma unroll
    for (int k = 0; k < 8; ++k) { const int c = k * 512 + tid, key = c & 255, d8 = c >> 8;
        const v4u v = *(const v4u*)(vbase + (size_t)key * 1024 + d8 * 8);
        LAS bf16* vt = (LAS bf16*)(lds + MA_KS) + (d8 * 8) * 264 + key;
        vt[0 * 264] = (bf16)(v.x & 0xffffu); vt[1 * 264] = (bf16)(v.x >> 16); vt[2 * 264] = (bf16)(v.y & 0xffffu); vt[3 * 264] = (bf16)(v.y >> 16);
        vt[4 * 264] = (bf16)(v.z & 0xffffu); vt[5 * 264] = (bf16)(v.z >> 16); vt[6 * 264] = (bf16)(v.w & 0xffffu); vt[7 * 264] = (bf16)(v.w >> 16); }
    __syncthreads();
    f32x4 oc[8];
#pragma unroll
    for (int dt = 0; dt < 8; ++dt) oc[dt] = (f32x4){0.f, 0.f, 0.f, 0.f};
#pragma unroll
    for (int ks = 0; ks < 8; ++ks) { const bf16x8 pa = *(const LAS bf16x8*)((LAS unsigned char*)Pw + fr * 528 + (32 * ks + 8 * fq) * 2);
#pragma unroll
        for (int dt = 0; dt < 8; ++dt) { const bf16x8 vb = *(const LAS bf16x8*)(lds + MA_KS + (16 * dt + fr) * 528 + (32 * ks + 8 * fq) * 2); oc[dt] = MFMA16(pa, vb, oc[dt]); } }
#pragma unroll
    for (int e = 0; e < 4; ++e) { const size_t m = (size_t)(m0 + 16 * w + 4 * fq + e); const float inv = 1.f / sm[e];
#pragma unroll
        for (int dt = 0; dt < 8; ++dt) QM[m * 512 + h * 128 + 16 * dt + fr] = (bf16)f2bf(oc[dt][e] * inv); }
    __syncthreads();
}

constexpr int LR_XR = 0, LR_XCF = 8704, LR_XCB = LR_XCF + 17408, LR_AU = LR_XCB + 9216, LR_SEG = LR_AU + 65536;
template <bool PHASE_B>
__device__ __forceinline__ void lru_item(const Params& p, int L, LAS unsigned char* lds, int item, const int tid) {
    const int lane = tid & 63, w = tid >> 6, fr = lane & 15, fq = lane >> 4;
    const int ci = item / 12, jb = item % 12, t0 = ci * 64;
    int cs, S;
    if (ci < 256) { cs = ci & 127; S = 8192; } else { cs = (ci - 256) & 31; S = 2048; }
    const bf16* QKVX = (const bf16*)(p.ws + WS_QKVX);
    for (int c = tid; c < 67 * 8; c += NTHR) { const int rr = c >> 3, d8 = c & 7, s = cs * 64 + rr - 1; v4u v = (v4u){0u, 0u, 0u, 0u};
        if (s >= 0 && s < S) v = *(const v4u*)(QKVX + (size_t)(t0 + rr - 1) * 3072 + 2304 + jb * 64 + d8 * 8);
        *(LAS v4u*)(lds + LR_XR + rr * 128 + d8 * 16) = v; }
    __syncthreads();
    { const int t = tid >> 3, c0 = (tid & 7) * 8; const float* cw = p.conv_w + (size_t)L * 4 * 768 + jb * 64 + c0; const float* cb = p.conv_b + (size_t)L * 768 + jb * 64 + c0;
      float xc[8];
#pragma unroll
      for (int e = 0; e < 8; ++e) xc[e] = cb[e];
#pragma unroll
      for (int j = 0; j < 4; ++j) { const v4u v = *(const LAS v4u*)(lds + LR_XR + (t + j) * 128 + c0 * 2); const float* wj = cw + j * 768;
          xc[0] += bflo(v.x) * wj[0]; xc[1] += bfhi(v.x) * wj[1]; xc[2] += bflo(v.y) * wj[2]; xc[3] += bfhi(v.y) * wj[3];
          xc[4] += bflo(v.z) * wj[4]; xc[5] += bfhi(v.z) * wj[5]; xc[6] += bflo(v.w) * wj[6]; xc[7] += bfhi(v.w) * wj[7]; }
      LAS float* xf = (LAS float*)(lds + LR_XCF) + t * 68 + c0;
      *(LAS f32x4*)xf = (f32x4){xc[0], xc[1], xc[2], xc[3]}; *(LAS f32x4*)(xf + 4) = (f32x4){xc[4], xc[5], xc[6], xc[7]};
      v4u o; o.x = pk2(xc[0], xc[1]); o.y = pk2(xc[2], xc[3]); o.z = pk2(xc[4], xc[5]); o.w = pk2(xc[6], xc[7]);
      *(LAS v4u*)(lds + LR_XCB + t * 144 + c0 * 2) = o; }
    __syncthreads();
    { const int rt = w & 3, dir = w >> 2;
      bf16x8 a[2];
#pragma unroll
      for (int ks = 0; ks < 2; ++ks) a[ks] = *(const LAS bf16x8*)(lds + LR_XCB + (16 * rt + fr) * 144 + (32 * ks + 8 * fq) * 2);
      const bf16* WL = (const bf16*)(p.ws + WS_WT) + WT_LRU + (size_t)((dir * 12 + jb) * 2) * 4096;
      const float* ba = p.lru_ba + (size_t)(L * 2 + dir) * 768 + jb * 64; const float* bx = p.lru_bx + (size_t)(L * 2 + dir) * 768 + jb * 64;
      const float* lam = p.lru_lambda + (size_t)(L * 2 + dir) * 768 + jb * 64;
#pragma unroll
      for (int ct = 0; ct < 4; ++ct) {
          f32x4 ga = (f32x4){0.f, 0.f, 0.f, 0.f}, gx = (f32x4){0.f, 0.f, 0.f, 0.f};
#pragma unroll
          for (int ks = 0; ks < 2; ++ks) {
              const bf16x8 wa = *(const bf16x8*)(WL + (size_t)(16 * ct + fr) * 64 + 32 * ks + 8 * fq);
              const bf16x8 wx = *(const bf16x8*)(WL + 4096 + (size_t)(16 * ct + fr) * 64 + 32 * ks + 8 * fq);
              ga = MFMA16(a[ks], wa, ga); gx = MFMA16(a[ks], wx, gx); }
          const int ch = 16 * ct + fr; const float bav = ba[ch], bxv = bx[ch], lm = lam[ch];
          const float sp = (lm > 15.f) ? __expf(-lm) : log1pf(__expf(-lm));
          const float c8 = 8.f * sp;
#pragma unroll
          for (int e = 0; e < 4; ++e) { const int t = 16 * rt + 4 * fq + e;
              const float r = 1.f / (1.f + __expf(-(ga[e] + bav))), ig = 1.f / (1.f + __expf(-(gx[e] + bxv)));
              const float la = -c8 * r; const float av = __expf(la); const float uu = sqrtf(-expm1f(2.f * la)) * (ig * ((const LAS float*)(lds + LR_XCF))[t * 68 + ch]);
              ((LAS f32x2*)(lds + LR_AU))[(dir * 64 + t) * 64 + ch] = (f32x2){av, uu}; } } }
    __syncthreads();
    const int sdir = tid >> 8, seg = (tid >> 6) & 3, ch = lane;
    LAS f32x2* AU = (LAS f32x2*)(lds + LR_AU) + sdir * 4096; LAS f32x2* SEG = (LAS f32x2*)(lds + LR_SEG) + sdir * 256;
    { float A = 1.f, H = 0.f;
#pragma unroll
      for (int k = 0; k < 16; ++k) { const int pp = seg * 16 + k, t = sdir ? 63 - pp : pp; const f32x2 au = AU[t * 64 + ch]; H = au.x * H + au.y; A *= au.x; }
      SEG[seg * 64 + ch] = (f32x2){A, H}; }
    __syncthreads();
    const size_t cidx = (size_t)(ci * 2 + sdir) * 768 + jb * 64 + ch;
    if constexpr (!PHASE_B) {
        if (seg == 0) { float A = 1.f, H = 0.f;
#pragma unroll
            for (int s = 0; s < 4; ++s) { const f32x2 sh = SEG[s * 64 + ch]; H = sh.x * H + sh.y; A *= sh.x; }
            ((f32x2*)(p.ws + WS_CAR))[cidx] = (f32x2){A, H}; }
        __syncthreads();
    } else {
        float h = ((const float*)(p.ws + WS_CIN))[cidx];
#pragma unroll
        for (int s = 0; s < 3; ++s) if (s < seg) { const f32x2 sh = SEG[s * 64 + ch]; h = sh.x * h + sh.y; }
#pragma unroll
        for (int k = 0; k < 16; ++k) { const int pp = seg * 16 + k, t = sdir ? 63 - pp : pp; const f32x2 au = AU[t * 64 + ch]; h = au.x * h + au.y; AU[t * 64 + ch].x = h; }
        __syncthreads();
        { const int t = tid >> 3, c0 = (tid & 7) * 8; bf16* gp = (bf16*)(p.ws + WS_GR) + (size_t)(t0 + t) * 768 + jb * 64 + c0;
          const v4u gv = *(const v4u*)gp; const LAS f32x2* A0 = (const LAS f32x2*)(lds + LR_AU) + t * 64 + c0; const LAS f32x2* A1 = A0 + 4096;
          v4u o;
          o.x = pk2(bflo(gv.x) * (A0[0].x + A1[0].x), bfhi(gv.x) * (A0[1].x + A1[1].x));
          o.y = pk2(bflo(gv.y) * (A0[2].x + A1[2].x), bfhi(gv.y) * (A0[3].x + A1[3].x));
          o.z = pk2(bflo(gv.z) * (A0[4].x + A1[4].x), bfhi(gv.z) * (A0[5].x + A1[5].x));
          o.w = pk2(bflo(gv.w) * (A0[6].x + A1[6].x), bfhi(gv.w) * (A0[7].x + A1[7].x));
          *(v4u*)gp = o; }
        __syncthreads();
    }
}

__device__ __forceinline__ void lru_carry(const Params& p, int gt) {
    if (gt >= 10 * 1536) return;
    const int seq = gt / 1536, rem = gt % 1536, dir = rem / 768, ch = rem % 768;
    int c0, nc; if (seq < 2) { c0 = seq * 128; nc = 128; } else { c0 = 256 + (seq - 2) * 32; nc = 32; }
    const f32x2* CAR = (const f32x2*)(p.ws + WS_CAR); float* CIN = (float*)(p.ws + WS_CIN);
    float h = 0.f;
    for (int k = 0; k < nc; k += 8) { f32x2 v[8];
#pragma unroll
        for (int j = 0; j < 8; ++j) { const int c = dir ? c0 + nc - 1 - (k + j) : c0 + k + j; v[j] = CAR[(size_t)(c * 2 + dir) * 768 + ch]; }
#pragma unroll
        for (int j = 0; j < 8; ++j) { const int c = dir ? c0 + nc - 1 - (k + j) : c0 + k + j; CIN[(size_t)(c * 2 + dir) * 768 + ch] = h; h = v[j].x * h + v[j].y; } }
}
__device__ __forceinline__ void attn_merge(const Params& p, int gt, int ngt) {
    const bf16* QKVX = (const bf16*)(p.ws + WS_QKVX); const float* LSE = (const float*)(p.ws + WS_LSE); bf16* AT = (bf16*)(p.ws + WS_ATTN);
    for (int idx = gt; idx < T * 32; idx += ngt) { const int m = idx >> 5, c8 = idx & 31, h = c8 >> 3;
        const float l0 = LSE[(size_t)m * 12 + h], l1 = LSE[(size_t)m * 12 + 4 + h], l2 = LSE[(size_t)m * 12 + 8 + h];
        const float mx = fmaxf(l0, fmaxf(l1, l2)); float w0 = __expf(l0 - mx), w1 = __expf(l1 - mx), w2 = __expf(l2 - mx); const float inv = 1.f / (w0 + w1 + w2); w0 *= inv; w1 *= inv; w2 *= inv;
        const bf16* o = QKVX + (size_t)m * 3072 + c8 * 8;
        const v4u a = *(const v4u*)o, b = *(const v4u*)(o + 256), c = *(const v4u*)(o + 512);
        v4u r;
        r.x = pk2(w0 * bflo(a.x) + w1 * bflo(b.x) + w2 * bflo(c.x), w0 * bfhi(a.x) + w1 * bfhi(b.x) + w2 * bfhi(c.x));
        r.y = pk2(w0 * bflo(a.y) + w1 * bflo(b.y) + w2 * bflo(c.y), w0 * bfhi(a.y) + w1 * bfhi(b.y) + w2 * bfhi(c.y));
        r.z = pk2(w0 * bflo(a.z) + w1 * bflo(b.z) + w2 * bflo(c.z), w0 * bfhi(a.z) + w1 * bfhi(b.z) + w2 * bfhi(c.z));
        r.w = pk2(w0 * bflo(a.w) + w1 * bflo(b.w) + w2 * bflo(c.w), w0 * bfhi(a.w) + w1 * bfhi(b.w) + w2 * bfhi(c.w));
        *(v4u*)(AT + (size_t)m * 256 + c8 * 8) = r; }
}

constexpr int N_PHASES = 27;
__global__ void __launch_bounds__(NTHR, 2) fwd_kernel(Params p) {
    extern __shared__ __attribute__((aligned(16))) unsigned char lds_raw[];
    LAS unsigned char* lds = (LAS unsigned char*)lds_raw;
    for (int ph = p.ph_lo; ph < p.ph_hi; ++ph) {
#if MEGA
        if (ph > p.ph_lo) cg::this_grid().sync();
#endif
        int tid_ = threadIdx.x; asm volatile("" : "+v"(tid_));
        int G_ = gridDim.x, bx_ = blockIdx.x; asm volatile("" : "+s"(G_), "+s"(bx_));
        const int tid = tid_, lane = tid & 63, wave = __builtin_amdgcn_readfirstlane(tid >> 6);
        const int G = G_, bx = bx_, gw = bx * NWAVES + wave, ngw = G * NWAVES;
        unsigned char* ws_ = p.ws; asm volatile("" : "+s"(ws_));
        bf16* WT = (bf16*)(ws_ + WS_WT); bf16* XB = (bf16*)(ws_ + WS_XB); bf16* ACT = (bf16*)(ws_ + WS_ACT);
        if (ph == 0) {
            if (PHON(13)) {
            cvt_weights(p, 0, lds, gw, ngw, wave, lane);
            for (int m = gw; m < T; m += ngw) cvt_row((m < 16384 ? p.x_prompt + (size_t)m * D : p.x_sample + (size_t)(m - 16384) * D), XB + (size_t)m * D, lane);
            bf16* MB = (bf16*)(p.ws + WS_MEMB);
            for (int m = gw; m < 2560; m += ngw) cvt_row((m < 512 ? p.mem_prompt + (size_t)m * D : p.mem_sample + (size_t)(m - 512) * D), MB + (size_t)m * D, lane);
            }
            continue;
        }
        const int L = (ph - 1) / 13, k = (ph - 1) % 13;
        if (PHON(0) && (k == 0 || k == 10)) {
            pg8::Gemm g{XB, WT + (k == 0 ? WT_FFIN0 : WT_FFIN1), T, 2 * DFF, D}; pg8::StaticOrder S; S.init(T, 2 * DFF, G, bx);
            pg8::EpiSwiglu E{ACT};
            pg8::gemm_phase<pg8::EpiSwiglu, pg8::StaticOrder, true, true>(lds, g, S, E);
        } else if (PHON(1) && (k == 1 || k == 11)) {
            pg8::Gemm g{ACT, WT + (k == 1 ? WT_FFOUT0 : WT_FFOUT1), T, D, DFF}; pg8::StaticOrder S; S.init(T, D, G, bx);
            const bool first = (L == 0 && k == 1);
            pg8::EpiResid E{first ? p.x_prompt : p.out, first ? p.x_sample - (size_t)16384 * D : p.out, p.out, ALPHA, 0.5f};
            pg8::gemm_phase<pg8::EpiResid, pg8::StaticOrder, true, true>(lds, g, S, E);
        } else if (PHON(2) && (k == 2 || k == 9 || k == 12)) {
            const int li = (k == 2) ? 0 : (k == 9 ? 1 : 2);
            const float* gg = p.ln_g + (size_t)(L * 3 + li) * D; const float* bb = p.ln_b + (size_t)(L * 3 + li) * D;
            const bool wbf = !(L == 1 && k == 12);
            for (int m = gw; m < T; m += ngw) ln_row(p.out + (size_t)m * D, XB + (size_t)m * D, gg, bb, lane, wbf);
            if (k == 2) {
                pg8::Gemm g{(const bf16*)(p.ws + WS_MEMB), WT + WT_MEMKV, 2560, 1024, D}; pg8::StaticOrder S; S.init(2560, 1024, G, bx);
                pg8::EpiBf16 E{(bf16*)(p.ws + WS_MEMKV), 1024, 0};
                pg8::gemm_phase<pg8::EpiBf16, pg8::StaticOrder, true, true>(lds, g, S, E);
            }
            if (k == 12 && L == 0) { __syncthreads(); cvt_weights(p, 1, lds, gw, ngw, wave, lane); }
        } else if (PHON(3) && k == 3) {
            pg8::Gemm g{XB, WT + WT_WIN, T, 4352, D}; pg8::StaticOrder S; S.init(T, 4352, G, bx);
            pg8::EpiWin E{(bf16*)(p.ws + WS_QKVX), (bf16*)(p.ws + WS_GR), (bf16*)(p.ws + WS_QM)};
            pg8::gemm_phase<pg8::EpiWin, pg8::StaticOrder, true, true>(lds, g, S, E);
        } else if (PHON(4) && k == 4) {
            for (int it = bx; it < 3072; it += G) attn_pair(p, lds, it * 2 + (tid >> 8), tid);
            for (int it = bx; it < 1024; it += G) memattn_item(p, lds, it, tid);
            for (int it = bx; it < NCHUNK * 12; it += G) lru_item<false>(p, L, lds, it, tid);
        } else if (PHON(5) && k == 5) {
            lru_carry(p, bx * NTHR + tid);
            attn_merge(p, bx * NTHR + tid, G * NTHR);
        } else if (PHON(6) && k == 6) {
            for (int it = bx; it < NCHUNK * 12; it += G) lru_item<true>(p, L, lds, it, tid);
        } else if (PHON(7) && k == 7) {
            bf16* GB = (bf16*)(p.ws + WS_QKVX);
            { pg8::Gemm g{(const bf16*)(p.ws + WS_ATTN), WT + WT_BRA, T, 1024, 256}; pg8::BrOrder S{G, bx, 0}; pg8::EpiBf16 E{GB, 3072, 0};
              pg8::gemm_phase<pg8::EpiBf16, pg8::BrOrder, true, true>(lds, g, S, E); }
            { pg8::Gemm g{(const bf16*)(p.ws + WS_GR), WT + WT_BRL, T, 1024, 768}; pg8::BrOrder S{G, bx, 1}; pg8::EpiBf16 E{GB, 3072, 1024};
              pg8::gemm_phase<pg8::EpiBf16, pg8::BrOrder, true, true>(lds, g, S, E); }
            { pg8::Gemm g{(const bf16*)(p.ws + WS_QM), WT + WT_BRM, T, 1024, 512}; pg8::BrOrder S{G, bx, 2}; pg8::EpiBf16 E{GB, 3072, 2048};
              pg8::gemm_phase<pg8::EpiBf16, pg8::BrOrder, true, true>(lds, g, S, E); }
            { pg8::Gemm g{XB, WT + WT_WIN + (size_t)4352 * 1024, T, 3072, D}; pg8::BrOrder S{G, bx, -1}; pg8::EpiGate E{GB, p.b_gate + (size_t)L * 3072};
              pg8::gemm_phase<pg8::EpiGate, pg8::BrOrder, true, true>(lds, g, S, E); }
        } else if (PHON(8) && k == 8) {
            pg8::Gemm g{(const bf16*)(p.ws + WS_QKVX), WT + WT_WOUT, T, D, 3072}; pg8::StaticOrder S; S.init(T, D, G, bx);
            pg8::EpiResid E{p.out, p.out, p.out, ALPHA, 1.0f};
            pg8::gemm_phase<pg8::EpiResid, pg8::StaticOrder, true, true>(lds, g, S, E);
        }
    }
}

extern "C" void kernel_launch(void* const* d_in, const int* in_sizes, int n_in, void* d_out, int out_size, void* d_ws, size_t ws_size, hipStream_t stream) {
    static int grid = 0;
    if (grid == 0) {
        if (n_in != 23 || out_size != T * D || ws_size < WS_END) { fprintf(stderr, "kernel_launch: unexpected shapes (n_in %d out %d ws %zu)\n", n_in, out_size, ws_size); grid = -1; return; }
        int dev = 0, cus = 0, per_cu = 0;
        hipGetDevice(&dev); hipDeviceGetAttribute(&cus, hipDeviceAttributeMultiprocessorCount, dev);
        hipFuncSetAttribute((const void*)fwd_kernel, hipFuncAttributeMaxDynamicSharedMemorySize, LDS_BYTES);
        hipOccupancyMaxActiveBlocksPerMultiprocessor(&per_cu, (const void*)fwd_kernel, NTHR, LDS_BYTES);
        (void)hipGetLastError();
        if (per_cu < 1) per_cu = 1;
        grid = cus;
        if (grid > 256) grid = 256;
    }
    if (grid < 0) return;
    Params p{};
    const float** pf = (const float**)&p;
    for (int i = 0; i < 23; ++i) pf[i] = (const float*)d_in[i];
    p.out = (float*)d_out; p.ws = (unsigned char*)d_ws;
#if MEGA
    p.ph_lo = 0; p.ph_hi = N_PHASES;
    void* args[] = {&p};
    hipError_t e = hipLaunchCooperativeKernel((const void*)fwd_kernel, dim3(grid), dim3(NTHR), args, LDS_BYTES, stream);
    if (e != hipSuccess) fprintf(stderr, "cooperative launch failed: %s (grid %d)\n", hipGetErrorString(e), grid);
#else
    for (int ph = 0; ph < N_PHASES; ++ph) { p.ph_lo = ph; p.ph_hi = ph + 1; hipLaunchKernelGGL(fwd_kernel, dim3(grid), dim3(NTHR), LDS_BYTES, stream, p); }
#endif
}
```

```cpp
#include <hip/hip_runtime.h>
#include <hip/hip_cooperative_groups.h>
#include <cstdio>
#include <cstdint>
namespace cg = cooperative_groups;

#ifndef MEGA
#define MEGA 1
#endif
#ifndef PH_MASK
#define PH_MASK 0xFFFF
#endif
#define PHON(b) ((PH_MASK >> (b)) & 1)

namespace pg8 {
#define PG8_LAS __attribute__((address_space(3)))
typedef unsigned short bf16_t;
typedef short bf16x8 __attribute__((ext_vector_type(8)));
typedef float f32x4 __attribute__((ext_vector_type(4)));
typedef unsigned u32x4 __attribute__((ext_vector_type(4)));
typedef unsigned u32x2 __attribute__((ext_vector_type(2)));
typedef float f32x2 __attribute__((ext_vector_type(2)));
constexpr int BM = 256, BK = 64, HALF = 128, HTB = HALF * BK * 2, STAGE_BYTES = 8 * HTB, NXCD = 8, WGM = 8;

__host__ __device__ __forceinline__ int lds_byte(int r, int c) { const int st = (r >> 4) * 2 + (c >> 5), rr = r & 15, cc = c & 31, ob = rr * 64 + cc * 2; return st * 1024 + (ob ^ (((ob >> 9) & 1) << 5)); }
__host__ __device__ __forceinline__ void stage_rc(int b, int& R, int& C) { const int st = b / 1024, sb = b % 1024, swz = sb ^ (((sb >> 9) & 1) << 5); R = (st >> 1) * 16 + swz / 64; C = (st & 1) * 32 + (swz % 64) / 2; }
__host__ __device__ __forceinline__ int perm32(int rho) { const int n = rho >> 4, i = rho & 15; return 8 * (i >> 2) + 4 * n + (i & 3); }

struct Unit { int pm, pn; };
struct Gemm { const bf16_t* A; const bf16_t* Bt; int M, N, K; int lda; };

struct StaticOrder {
    int nM, nN, nwg, G, c;
    __device__ void init(int M, int N, int G_, int c_) { nM = M / BM; nN = N / BM; nwg = nM * nN; G = G_; c = c_; }
    __device__ bool next(int i, Unit& u) const {
        const long L = (long)i * G + c; if (L >= nwg) return false;
        int wgid = (int)L; { const int q = nwg / NXCD, r = nwg % NXCD, xcd = wgid % NXCD, off = wgid / NXCD; wgid = (xcd < r ? xcd * (q + 1) : r * (q + 1) + (xcd - r) * q) + off; }
        const int nig = WGM * nN, gid = wgid / nig, fm = gid * WGM, gsz = (nM - fm) < WGM ? (nM - fm) : WGM;
        u.pm = fm + ((wgid % nig) % gsz); u.pn = (wgid % nig) / gsz; return true;
    }
    __device__ __forceinline__ void a_ready(const Unit&) const {}
    __device__ __forceinline__ void done(const Unit&) const {}
};
struct MgOrder {
    int G, c, b;
    __device__ bool next(int i, Unit& u) const {
        const int ti = b < 0 ? i / 3 : i, br = b < 0 ? i - 3 * ti : 0; int pm, pn;
        if (G == 256) {
            if (ti >= 2) return false; const int x = c & 7, idx = c >> 3; pm = 8 * (ti * 8 + x) + (idx & 7); pn = idx >> 3;
        } else { const int L = c + ti * G; if (L >= 512) return false; pm = L >> 2; pn = L & 3; }
        u.pm = pm; u.pn = pn + 4 * br; return true;
    }
    __device__ __forceinline__ void a_ready(const Unit&) const {}
    __device__ __forceinline__ void done(const Unit&) const {}
};

__device__ __forceinline__ unsigned cvt_pk_bf16(float lo, float hi) { unsigned r; asm volatile("v_cvt_pk_bf16_f32 %0, %1, %2" : "=v"(r) : "v"(lo), "v"(hi)); return r; }
__device__ __forceinline__ float bf_lo(unsigned w) { return __builtin_bit_cast(float, w << 16); }
__device__ __forceinline__ float bf_hi(unsigned w) { return __builtin_bit_cast(float, w & 0xffff0000u); }
__device__ __forceinline__ float fsigmoid(float x) { return __builtin_amdgcn_rcpf(1.f + __expf(-x)); }
__device__ __forceinline__ float fgelu_tanh(float x) { const float u = 0.7978845608028654f * (x + 0.044715f * x * x * x); return x * fsigmoid(2.f * u); }


struct EpiSwiglu {
    static constexpr bool PERM = true, AFTER_DRAIN = false;
    bf16_t* O;
    __device__ __forceinline__ void operator()(const f32x4 (&acc)[2][2][4][2], const Unit& u, int wr, int wc, int fr, int fq) const {
        const int row0 = u.pm * BM + wr * 64 + fr, col0 = u.pn * HALF + wc * 32 + 8 * fq;
#pragma unroll
        for (int ai = 0; ai < 2; ++ai)
#pragma unroll
            for (int m = 0; m < 4; ++m) { const f32x4 g0 = acc[ai][0][m][0], g1 = acc[ai][0][m][1], u0 = acc[ai][1][m][0], u1 = acc[ai][1][m][1];
                u32x4 w;
                w.x = cvt_pk_bf16(g0[0] * fsigmoid(g0[0]) * u0[0], g0[1] * fsigmoid(g0[1]) * u0[1]); w.y = cvt_pk_bf16(g0[2] * fsigmoid(g0[2]) * u0[2], g0[3] * fsigmoid(g0[3]) * u0[3]);
                w.z = cvt_pk_bf16(g1[0] * fsigmoid(g1[0]) * u1[0], g1[1] * fsigmoid(g1[1]) * u1[1]); w.w = cvt_pk_bf16(g1[2] * fsigmoid(g1[2]) * u1[2], g1[3] * fsigmoid(g1[3]) * u1[3]);
                *(u32x4*)(O + (size_t)(row0 + ai * HALF + m * 16) * 2816 + col0) = w; }
    }
};
typedef _Float16 h16x8 __attribute__((ext_vector_type(8)));
typedef _Float16 h16x4 __attribute__((ext_vector_type(4)));
struct EpiResid {
    static constexpr bool PERM = true, AFTER_DRAIN = false;
    const float* base_lo; const float* base_hi; _Float16* z16; float alpha, s;
    const float* const* lnp; unsigned char* const* wsp; int lnidx;
    __device__ __forceinline__ void operator()(const f32x4 (&acc)[2][2][4][2], const Unit& u, int wr, int wc, int fr, int fq) const {
        const int col0 = u.pn * BM + wc * 32 + 8 * fq;
        if (lnidx >= 0) {
            const float* stats = (const float*)(*wsp + 262144); const float* lg = lnp[0] + (size_t)lnidx * 1024; const float* lb = lnp[1] + (size_t)lnidx * 1024;
            float mean[2][4], rstd[2][4];
#pragma unroll
            for (int ai = 0; ai < 2; ++ai)
#pragma unroll
                for (int m = 0; m < 4; ++m) { const f32x2 st = *(const f32x2*)(stats + 2 * (size_t)(u.pm * BM + ai * HALF + wr * 64 + m * 16 + fr)); mean[ai][m] = st.x; rstd[ai][m] = st.y * alpha; }
#pragma unroll
            for (int bj = 0; bj < 2; ++bj) { const f32x4 g0 = *(const f32x4*)(lg + col0 + bj * HALF), g1 = *(const f32x4*)(lg + col0 + bj * HALF + 4), b0 = *(const f32x4*)(lb + col0 + bj * HALF) * alpha, b1 = *(const f32x4*)(lb + col0 + bj * HALF + 4) * alpha;
#pragma unroll
                for (int ai = 0; ai < 2; ++ai)
#pragma unroll
                    for (int m = 0; m < 4; ++m) { _Float16* zp = z16 + (size_t)(u.pm * BM + ai * HALF + wr * 64 + m * 16 + fr) * 1024 + col0 + bj * HALF;
                        const h16x8 zh = *(const h16x8*)zp;
                        const f32x4 z0 = __builtin_convertvector(__builtin_shufflevector(zh, zh, 0, 1, 2, 3), f32x4), z1 = __builtin_convertvector(__builtin_shufflevector(zh, zh, 4, 5, 6, 7), f32x4);
                        const f32x4 o0 = (z0 - mean[ai][m]) * rstd[ai][m] * g0 + b0 + acc[ai][bj][m][0] * s, o1 = (z1 - mean[ai][m]) * rstd[ai][m] * g1 + b1 + acc[ai][bj][m][1] * s;
                        const h16x4 h0 = __builtin_convertvector(o0, h16x4), h1 = __builtin_convertvector(o1, h16x4);
                        *(h16x8*)zp = __builtin_shufflevector(h0, h1, 0, 1, 2, 3, 4, 5, 6, 7); }
                asm volatile("" ::: "memory"); }
        } else {
            const float* base = (u.pm < 64) ? base_lo : base_hi;
#pragma unroll
            for (int ai = 0; ai < 2; ++ai)
#pragma unroll
                for (int m = 0; m < 4; ++m) { const size_t off = (size_t)(u.pm * BM + ai * HALF + wr * 64 + m * 16 + fr) * 1024 + col0;
#pragma unroll
                    for (int bj = 0; bj < 2; ++bj) { const f32x4 x0 = *(const f32x4*)(base + off + bj * HALF), x1 = *(const f32x4*)(base + off + bj * HALF + 4);
                        const f32x4 o0 = x0 * alpha + acc[ai][bj][m][0] * s, o1 = x1 * alpha + acc[ai][bj][m][1] * s;
                        const h16x4 h0 = __builtin_convertvector(o0, h16x4), h1 = __builtin_convertvector(o1, h16x4);
                        *(h16x8*)(z16 + off + bj * HALF) = __builtin_shufflevector(h0, h1, 0, 1, 2, 3, 4, 5, 6, 7); } }
        }
    }
};
struct EpiBf16 {
    static constexpr bool PERM = true, AFTER_DRAIN = false;
    bf16_t* O; int ldc, coff;
    __device__ __forceinline__ void operator()(const f32x4 (&acc)[2][2][4][2], const Unit& u, int wr, int wc, int fr, int fq) const {
        const int row0 = u.pm * BM + wr * 64 + fr, col0 = coff + u.pn * BM + wc * 32 + 8 * fq;
#pragma unroll
        for (int ai = 0; ai < 2; ++ai)
#pragma unroll
            for (int m = 0; m < 4; ++m) { bf16_t* rowp = O + (size_t)(row0 + ai * HALF + m * 16) * ldc + col0;
#pragma unroll
                for (int bj = 0; bj < 2; ++bj) { const f32x4 v0 = acc[ai][bj][m][0], v1 = acc[ai][bj][m][1];
                    u32x4 w; w.x = cvt_pk_bf16(v0[0], v0[1]); w.y = cvt_pk_bf16(v0[2], v0[3]); w.z = cvt_pk_bf16(v1[0], v1[1]); w.w = cvt_pk_bf16(v1[2], v1[3]);
                    *(u32x4*)(rowp + bj * HALF) = w; } }
    }
};
struct EpiWin {
    static constexpr bool PERM = true, AFTER_DRAIN = false;
    bf16_t* QKVX; bf16_t* GR; bf16_t* QM;
    __device__ __forceinline__ void operator()(const f32x4 (&acc)[2][2][4][2], const Unit& u, int wr, int wc, int fr, int fq) const {
        const int row0 = u.pm * BM + wr * 64 + fr; const int pn = u.pn;
        bf16_t* base; int ldc, colt; float sc = 1.f; bool gel = false;
        if (pn < 12) { base = QKVX; ldc = 3072; colt = pn * BM; if (pn < 3) sc = 0.125f; }
        else if (pn < 15) { base = GR; ldc = 768; colt = (pn - 12) * BM; gel = true; }
        else { base = QM; ldc = 512; colt = (pn - 15) * BM; sc = 0.08838834764831845f; }
        const int col0 = colt + wc * 32 + 8 * fq;
#pragma unroll
        for (int ai = 0; ai < 2; ++ai)
#pragma unroll
            for (int m = 0; m < 4; ++m) { bf16_t* rowp = base + (size_t)(row0 + ai * HALF + m * 16) * ldc + col0;
#pragma unroll
                for (int bj = 0; bj < 2; ++bj) { f32x4 v0 = acc[ai][bj][m][0], v1 = acc[ai][bj][m][1];
                    if (gel) {
#pragma unroll
                        for (int e = 0; e < 4; ++e) { v0[e] = fgelu_tanh(v0[e]); v1[e] = fgelu_tanh(v1[e]); } }
                    v0 = v0 * sc; v1 = v1 * sc;
                    u32x4 w; w.x = cvt_pk_bf16(v0[0], v0[1]); w.y = cvt_pk_bf16(v0[2], v0[3]); w.z = cvt_pk_bf16(v1[0], v1[1]); w.w = cvt_pk_bf16(v1[2], v1[3]);
                    *(u32x4*)(rowp + bj * HALF) = w; } }
    }
};
struct EpiGate {
    static constexpr bool PERM = true, AFTER_DRAIN = false;
    bf16_t* G; const float* bg;
    __device__ __forceinline__ void operator()(const f32x4 (&acc)[2][2][4][2], const Unit& u, int wr, int wc, int fr, int fq) const {
        const int br = u.pn >> 2, row0 = u.pm * BM + wr * 64 + fr, col0 = (u.pn & 3) * BM + wc * 32 + 8 * fq;
#pragma unroll
        for (int bj = 0; bj < 2; ++bj) { const f32x4 b0 = *(const f32x4*)(bg + br * 1024 + col0 + bj * HALF), b1 = *(const f32x4*)(bg + br * 1024 + col0 + bj * HALF + 4);
#pragma unroll
            for (int ai = 0; ai < 2; ++ai)
#pragma unroll
                for (int m = 0; m < 4; ++m) { bf16_t* pm_ = G + (size_t)(row0 + ai * HALF + m * 16) * 3072 + col0 + bj * HALF;
                    const u32x4 pv = *(const u32x4*)(pm_ + br * 1024); u32x4 mv = (u32x4){0u, 0u, 0u, 0u}; if (br) mv = *(const u32x4*)pm_;
                    const f32x4 v0 = acc[ai][bj][m][0] + b0, v1 = acc[ai][bj][m][1] + b1;
                    u32x4 w;
                    w.x = cvt_pk_bf16(bf_lo(mv.x) + fsigmoid(v0[0]) * bf_lo(pv.x), bf_hi(mv.x) + fsigmoid(v0[1]) * bf_hi(pv.x));
                    w.y = cvt_pk_bf16(bf_lo(mv.y) + fsigmoid(v0[2]) * bf_lo(pv.y), bf_hi(mv.y) + fsigmoid(v0[3]) * bf_hi(pv.y));
                    w.z = cvt_pk_bf16(bf_lo(mv.z) + fsigmoid(v1[0]) * bf_lo(pv.z), bf_hi(mv.z) + fsigmoid(v1[1]) * bf_hi(pv.z));
                    w.w = cvt_pk_bf16(bf_lo(mv.w) + fsigmoid(v1[2]) * bf_lo(pv.w), bf_hi(mv.w) + fsigmoid(v1[3]) * bf_hi(pv.w));
                    *(u32x4*)pm_ = w; } }
    }
};

template <class Epi, class Sched, bool ALIGN_EPI = false, bool SP2 = false>
__device__ __forceinline__ void gemm_phase(PG8_LAS unsigned char* lds, const Gemm g, const Sched& S, const Epi& E) {
    int tid_ = threadIdx.x; asm volatile("" : "+v"(tid_));
    const int tid = tid_, wid = __builtin_amdgcn_readfirstlane(tid >> 6), lane = tid & 63, wr = wid >> 2, wc = wid & 3, fr = lane & 15, fq = lane >> 4;
    const int K = g.K, nt = K / BK;
    unsigned voffA[2], voffB[2];
#pragma unroll
    for (int i = 0; i < 2; ++i) { int R, C; stage_rc(tid * 16 + i * 8192, R, C); const int Rb = Epi::PERM ? ((R & ~31) + perm32(R & 31)) : R;
        voffA[i] = (unsigned)(R * g.lda + C) * 2u; voffB[i] = (unsigned)(Rb * K + C) * 2u; }
    const size_t kstep = (size_t)(BK * 2);
    const size_t hstep = (size_t)HALF * K * 2, hstepA = (size_t)HALF * g.lda * 2;
    const size_t tstep = 2 * hstep, tstepA = 2 * hstepA;
    const unsigned ldsw = (unsigned)wid * 1024u;
    const int aoff = lds_byte(wr * 64 + fr, fq * 8), boff = lds_byte(wc * 32 + fr, fq * 8);
#define PG8_SA(b, h) (((b) * 2 + (h)) * HTB)
#define PG8_SB(b, h) ((4 + (b) * 2 + (h)) * HTB)
#define PG8_STAGE(bufoff, gbase, voff) do { _Pragma("unroll") for (int _i = 0; _i < 2; ++_i) \
        __builtin_amdgcn_global_load_lds((const unsigned*)((const char*)(gbase) + (voff)[_i]), (PG8_LAS unsigned*)(lds + (bufoff) + ldsw + _i * 8192), 16, 0, 0); } while (0)
#define PG8_LDA(dst, b, h) do { _Pragma("unroll") for (int m = 0; m < 4; ++m) _Pragma("unroll") for (int k = 0; k < 2; ++k) dst[m][k] = *(const PG8_LAS bf16x8*)(lds + PG8_SA(b, h) + aoff + m * 2048 + k * 1024); } while (0)
#define PG8_LDB(dst, b, h) do { _Pragma("unroll") for (int n = 0; n < 2; ++n) _Pragma("unroll") for (int k = 0; k < 2; ++k) dst[n][k] = *(const PG8_LAS bf16x8*)(lds + PG8_SB(b, h) + boff + n * 2048 + k * 1024); } while (0)
#define PG8_MMA(ai, bj, At, Bt) do { __builtin_amdgcn_s_setprio(1); _Pragma("unroll") for (int m = 0; m < 4; ++m) _Pragma("unroll") for (int n = 0; n < 2; ++n) _Pragma("unroll") for (int k = 0; k < 2; ++k) \
        acc[ai][bj][m][n] = __builtin_amdgcn_mfma_f32_16x16x32_bf16(Bt[n][k], At[m][k], acc[ai][bj][m][n], 0, 0, 0); __builtin_amdgcn_s_setprio(0); } while (0)
#define PG8_WAIT_V(n) asm volatile("s_waitcnt vmcnt(" #n ")" ::: "memory")
#define PG8_WAIT_L(n) asm volatile("s_waitcnt lgkmcnt(" #n ")" ::: "memory")
#define PG8_BAR __builtin_amdgcn_s_barrier()
#define PG8_SCHED __builtin_amdgcn_sched_barrier(0)
    Unit cur, nxt; int ui = 0;
    if (!S.next(0, cur)) return;
    f32x4 acc[2][2][4][2];
#pragma unroll
    for (int a = 0; a < 2; ++a)
#pragma unroll
        for (int b = 0; b < 2; ++b)
#pragma unroll
            for (int m = 0; m < 4; ++m)
#pragma unroll
                for (int n = 0; n < 2; ++n) acc[a][b][m][n] = (f32x4){0.f, 0.f, 0.f, 0.f};
    bf16x8 At[4][2], B0[2][2], B1[2][2];
    const char* cA = (const char*)g.A + (size_t)cur.pm * tstepA; const char* cB = (const char*)g.Bt + (size_t)cur.pn * tstep;
    S.a_ready(cur);
    if constexpr (SP2) {
        PG8_STAGE(PG8_SB(0, 0), cB, voffB); PG8_STAGE(PG8_SB(0, 1), cB + hstep, voffB); PG8_STAGE(PG8_SA(0, 0), cA, voffA); PG8_STAGE(PG8_SA(0, 1), cA + hstepA, voffA);
        if (wr == 1) PG8_BAR;
        PG8_WAIT_V(2); PG8_BAR;
        PG8_STAGE(PG8_SB(1, 0), cB + kstep, voffB); PG8_STAGE(PG8_SA(1, 0), cA + kstep, voffA); PG8_STAGE(PG8_SB(1, 1), cB + hstep + kstep, voffB);
        PG8_WAIT_V(6); PG8_BAR;
    } else {
        PG8_STAGE(PG8_SB(0, 0), cB, voffB); PG8_STAGE(PG8_SA(0, 0), cA, voffA); PG8_STAGE(PG8_SB(0, 1), cB + hstep, voffB); PG8_STAGE(PG8_SA(0, 1), cA + hstepA, voffA);
        if (wr == 1) PG8_BAR;
        PG8_WAIT_V(4); PG8_BAR;
        PG8_STAGE(PG8_SB(1, 0), cB + kstep, voffB); PG8_STAGE(PG8_SA(1, 0), cA + kstep, voffA); PG8_STAGE(PG8_SB(1, 1), cB + hstep + kstep, voffB);
        PG8_WAIT_V(6); PG8_BAR;
    }
    for (;;) {
        const bool has_next = S.next(ui + 1, nxt);
        const char* nA = has_next ? (const char*)g.A + (size_t)nxt.pm * tstepA : cA; const char* nB = has_next ? (const char*)g.Bt + (size_t)nxt.pn * tstep : cB;
        for (int t = 0; t < nt; t += 2) {
            const bool last = (t == nt - 2);
            const char* a1 = cA + (size_t)(t + 1) * kstep;
            const char* a2 = last ? nA : cA + (size_t)(t + 2) * kstep; const char* b2 = last ? nB : cB + (size_t)(t + 2) * kstep;
            const char* a3 = a2 + kstep; const char* b3 = b2 + kstep;
            if (last && has_next) S.a_ready(nxt);
            if constexpr (SP2) {
            PG8_LDB(B0, 0, 0); PG8_LDB(B1, 0, 1); PG8_SCHED; PG8_LDA(At, 0, 0); PG8_STAGE(PG8_SA(1, 1), a1 + hstepA, voffA);
            PG8_WAIT_V(8); PG8_WAIT_L(0); PG8_BAR; PG8_MMA(0, 0, At, B0); PG8_MMA(0, 1, At, B1); PG8_BAR; PG8_SCHED;
            PG8_LDA(At, 0, 1); PG8_STAGE(PG8_SB(0, 0), b2, voffB); PG8_STAGE(PG8_SB(0, 1), b2 + hstep, voffB); PG8_STAGE(PG8_SA(0, 0), a2, voffA);
            PG8_WAIT_V(8); PG8_WAIT_L(0); PG8_BAR; PG8_MMA(1, 0, At, B0); PG8_MMA(1, 1, At, B1); PG8_BAR; PG8_SCHED;
            PG8_LDB(B0, 1, 0); PG8_LDB(B1, 1, 1); PG8_SCHED; PG8_LDA(At, 1, 0); PG8_STAGE(PG8_SA(0, 1), a2 + hstepA, voffA);
            PG8_WAIT_V(8); PG8_WAIT_L(0); PG8_BAR; PG8_MMA(0, 0, At, B0); PG8_MMA(0, 1, At, B1); PG8_BAR; PG8_SCHED;
            PG8_LDA(At, 1, 1); PG8_STAGE(PG8_SB(1, 0), b3, voffB); PG8_STAGE(PG8_SB(1, 1), b3 + hstep, voffB); PG8_STAGE(PG8_SA(1, 0), a3, voffA);
            PG8_WAIT_V(8); PG8_WAIT_L(0); PG8_BAR; PG8_MMA(1, 0, At, B0); PG8_MMA(1, 1, At, B1); PG8_BAR; PG8_SCHED;
            } else {
            PG8_LDB(B0, 0, 0); PG8_SCHED; PG8_LDA(At, 0, 0); PG8_STAGE(PG8_SA(1, 1), a1 + hstepA, voffA);
            PG8_WAIT_L(8); PG8_BAR; PG8_WAIT_L(0); PG8_MMA(0, 0, At, B0); PG8_BAR; PG8_SCHED;
            PG8_LDB(B1, 0, 1); PG8_STAGE(PG8_SB(0, 0), b2, voffB);
            PG8_BAR; PG8_WAIT_L(0); PG8_MMA(0, 1, At, B1); PG8_BAR;
            PG8_LDA(At, 0, 1); PG8_STAGE(PG8_SA(0, 0), a2, voffA);
            PG8_BAR; PG8_WAIT_L(0); PG8_MMA(1, 0, At, B0); PG8_BAR; PG8_SCHED;
            PG8_STAGE(PG8_SB(0, 1), b2 + hstep, voffB);
            PG8_WAIT_V(6); PG8_BAR; PG8_MMA(1, 1, At, B1); PG8_BAR;
            PG8_LDB(B0, 1, 0); PG8_SCHED; PG8_LDA(At, 1, 0); PG8_STAGE(PG8_SA(0, 1), a2 + hstepA, voffA);
            PG8_WAIT_L(8); PG8_BAR; PG8_WAIT_L(0); PG8_MMA(0, 0, At, B0); PG8_BAR; PG8_SCHED;
            PG8_LDB(B1, 1, 1); PG8_STAGE(PG8_SB(1, 0), b3, voffB);
            PG8_BAR; PG8_WAIT_L(0); PG8_MMA(0, 1, At, B1); PG8_BAR;
            PG8_LDA(At, 1, 1); PG8_STAGE(PG8_SA(1, 0), a3, voffA);
            PG8_BAR; PG8_WAIT_L(0); PG8_MMA(1, 0, At, B0); PG8_BAR; PG8_SCHED;
            PG8_STAGE(PG8_SB(1, 1), b3 + hstep, voffB);
            PG8_WAIT_V(6); PG8_BAR; PG8_MMA(1, 1, At, B1); PG8_BAR;
            }
        }
        if constexpr (ALIGN_EPI) { if (wr == 0) PG8_BAR; }
        if constexpr (!Epi::AFTER_DRAIN) { E(acc, cur, wr, wc, fr, fq); S.done(cur); }
        if (!has_next) break;
#pragma unroll
        for (int a = 0; a < 2; ++a)
#pragma unroll
            for (int b = 0; b < 2; ++b)
#pragma unroll
                for (int m = 0; m < 4; ++m)
#pragma unroll
                    for (int n = 0; n < 2; ++n) acc[a][b][m][n] = (f32x4){0.f, 0.f, 0.f, 0.f};
        cur = nxt; cA = nA; cB = nB; ++ui;
        if constexpr (ALIGN_EPI) { if (wr == 1) PG8_BAR; }
    }
    PG8_WAIT_V(0);
    if constexpr (!ALIGN_EPI) { if (wr == 0) PG8_BAR; }
    PG8_BAR;
#undef PG8_SA
#undef PG8_SB
#undef PG8_STAGE
#undef PG8_LDA
#undef PG8_LDB
#undef PG8_MMA
#undef PG8_WAIT_V
#undef PG8_WAIT_L
#undef PG8_BAR
#undef PG8_SCHED
}
}

#define LAS __attribute__((address_space(3)))
typedef unsigned short bf16;
typedef unsigned v4u __attribute__((ext_vector_type(4)));
typedef float f32x4 __attribute__((ext_vector_type(4)));
typedef float f32x2 __attribute__((ext_vector_type(2)));
typedef short bf16x8 __attribute__((ext_vector_type(8)));
constexpr int T = 32768, D = 1024, DFF = 2816, NCHUNK = T / 64, DIN = 7424;
constexpr int NWAVES = 8, NTHR = 512;
constexpr float ALPHA = 1.4142135623730951f, LN_EPS = 1e-5f;
constexpr int LDS_BYTES = 147456;
constexpr size_t MiB = 1u << 20;
constexpr size_t WS_WT = 1 * MiB, WS_XB = 61 * MiB, WS_MEMB = 125 * MiB, WS_MEMKV = 130 * MiB, WS_CAR = 135 * MiB, WS_CIN = 141 * MiB, WS_LSE = 144 * MiB,
                 WS_QKVX = 146 * MiB, WS_ACT = 146 * MiB, WS_GR = 338 * MiB, WS_QM = 386 * MiB, WS_ATTN = 418 * MiB, WS_Z16 = 434 * MiB, WS_END = 498 * MiB;
constexpr size_t WT_FFIN0 = 0, WT_FFIN1 = 5767168, WT_FFOUT0 = 11534336, WT_FFOUT1 = 14417920, WT_WIN = 17301504, WT_MEMKV = 24903680,
                 WT_BRA = 25952256, WT_BRL = 26214400, WT_BRM = 27000832, WT_WOUT = 27525120, WT_LRU = 30670848, WT_END = 30867456;
static_assert(WT_END * 2 <= 60 * MiB, "weights fit");

struct Params {
    const float* x_prompt; const float* x_sample; const float* mem_prompt; const float* mem_sample; const float* rel_bias;
    const float* w_in; const float* b_gate; const float* conv_w; const float* conv_b; const float* lru_wa; const float* lru_ba;
    const float* lru_wx; const float* lru_bx; const float* lru_lambda; const float* w_mem_kv; const float* w_br_attn; const float* w_br_lru;
    const float* w_br_mem; const float* w_out; const float* ff_in; const float* ff_out; const float* ln_g; const float* ln_b;
    float* out; unsigned char* ws; int ph_lo, ph_hi;
};

__device__ __forceinline__ unsigned f2bf(float f) { unsigned u = __builtin_bit_cast(unsigned, f); return (u + 0x7fffu + ((u >> 16) & 1u)) >> 16; }
__device__ __forceinline__ unsigned pk2(float lo, float hi) { return f2bf(lo) | (f2bf(hi) << 16); }
__device__ __forceinline__ float bflo(unsigned w) { return __builtin_bit_cast(float, w << 16); }
__device__ __forceinline__ float bfhi(unsigned w) { return __builtin_bit_cast(float, w & 0xffff0000u); }
__device__ __forceinline__ float wave_sum(float v) {
#pragma unroll
    for (int o = 1; o < 64; o <<= 1) v += __shfl_xor(v, o);
    return v;
}
#define LDS_WAIT() asm volatile("s_waitcnt lgkmcnt(0)" ::: "memory")

__device__ __forceinline__ void cvt_item(const float* W, int ldw, bf16* WT, int pitch, int drow0, int k0, int n0, LAS float* scr, int lane) {
    float wv[32];
#pragma unroll
    for (int i = 0; i < 32; ++i) wv[i] = W[(size_t)(k0 + 2 * i + (lane >> 5)) * ldw + n0 + (lane & 31)];
#pragma unroll
    for (int i = 0; i < 32; ++i) scr[(2 * i + (lane >> 5)) * 33 + (lane & 31)] = wv[i];
    LDS_WAIT(); asm volatile("" ::: "memory");
    const int c = lane & 7;
#pragma unroll
    for (int j = 0; j < 4; ++j) { const int n = (lane >> 3) + 8 * j; const LAS float* s = scr + (8 * c) * 33 + n;
        v4u o; o.x = pk2(s[0 * 33], s[1 * 33]); o.y = pk2(s[2 * 33], s[3 * 33]); o.z = pk2(s[4 * 33], s[5 * 33]); o.w = pk2(s[6 * 33], s[7 * 33]);
        *(v4u*)(WT + (size_t)(drow0 + n) * pitch + k0 + 8 * c) = o; }
    LDS_WAIT(); asm volatile("" ::: "memory");
}
constexpr int CVT_ITEMS = 14048;
__device__ __forceinline__ void cvt_weights(const Params& p, int L, LAS unsigned char* lds, int gw, int ngw, int wave, int lane) {
    LAS float* scr = (LAS float*)(lds + wave * 16384);
    bf16* WT = (bf16*)(p.ws + WS_WT);
    for (int i = gw * 64 + lane; i < 1536; i += ngw * 64) { const float lm = p.lru_lambda[(size_t)L * 1536 + i]; ((float*)(p.ws + 65536))[i] = 8.f * ((lm > 15.f) ? __expf(-lm) : log1pf(__expf(-lm))); }
    for (int it = gw; it < CVT_ITEMS; it += ngw) {
        int r = it; const float* src; int ldw, K, Nc, pitch, gu = -1; bf16* dst;
        if (r < 5632) { const int j = r / 1408; r -= j * 1408; const int f = j >> 1, up = j & 1;
            src = p.ff_in + (size_t)(L * 2 + f) * 1024 * 5632 + up * 2816; ldw = 5632; K = 1024; Nc = 2816; dst = WT + (f ? WT_FFIN1 : WT_FFIN0); pitch = 1024; gu = up; }
        else if ((r -= 5632) < 2816) { const int f = r / 1408; r -= f * 1408;
            src = p.ff_out + (size_t)(L * 2 + f) * 2816 * 1024; ldw = 1024; K = 2816; Nc = 1024; dst = WT + (f ? WT_FFOUT1 : WT_FFOUT0); pitch = 2816; }
        else if ((r -= 2816) < 3712) { src = p.w_in + (size_t)L * 1024 * DIN; ldw = DIN; K = 1024; Nc = DIN; dst = WT + WT_WIN; pitch = 1024; }
        else if ((r -= 3712) < 512) { src = p.w_mem_kv + (size_t)L * 1024 * 1024; ldw = 1024; K = 1024; Nc = 1024; dst = WT + WT_MEMKV; pitch = 1024; }
        else if ((r -= 512) < 128) { src = p.w_br_attn + (size_t)L * 256 * 1024; ldw = 1024; K = 256; Nc = 1024; dst = WT + WT_BRA; pitch = 256; }
        else if ((r -= 128) < 384) { src = p.w_br_lru + (size_t)L * 768 * 1024; ldw = 1024; K = 768; Nc = 1024; dst = WT + WT_BRL; pitch = 768; }
        else if ((r -= 384) < 256) { src = p.w_br_mem + (size_t)L * 512 * 1024; ldw = 1024; K = 512; Nc = 1024; dst = WT + WT_BRM; pitch = 512; }
        else if ((r -= 256) < 512) { src = p.w_out + (size_t)L * 1024 * 1024; ldw = 1024; K = 1024; Nc = 1024; dst = WT + WT_WOUT; pitch = 1024; }
        else { r -= 512; const int mi = r >> 1; r &= 1; const int g = mi / 24, dir = (mi % 24) / 12, blk = mi % 12;
            src = (g ? p.lru_wx : p.lru_wa) + (size_t)((L * 2 + dir) * 12 + blk) * 4096; ldw = 64; K = 64; Nc = 64; dst = WT + WT_LRU + (size_t)(((dir * 12 + blk) * 2 + g) * 64) * 64; pitch = 64; }
        const int nblk = Nc / 32, kb = r / nblk, nb = r % nblk;
        const int n0 = 32 * nb, drow0 = gu < 0 ? n0 : (n0 >> 7) * 256 + (n0 & 127) + gu * 128;
        cvt_item(src, ldw, dst, pitch, drow0, 64 * kb, n0, scr, lane);
    }
}
__device__ __forceinline__ void cvt_row(const float* xrow, bf16* orow, int lane) {
    const f32x4* xr = (const f32x4*)xrow + lane; unsigned long long* o8 = (unsigned long long*)orow + lane;
#pragma unroll
    for (int j = 0; j < 4; ++j) { const f32x4 v = xr[64 * j]; o8[64 * j] = (unsigned long long)pk2(v.x, v.y) | ((unsigned long long)pk2(v.z, v.w) << 32); }
}
template <int NR>
__device__ __forceinline__ void ln_rows(const _Float16* z, bf16* xb, float* st, float* outf, int m0, int stride, const float* g, const float* b, int lane, bool final_out) {
    typedef _Float16 h16x4 __attribute__((ext_vector_type(4)));
    f32x4 v[NR][4]; float s[NR];
#pragma unroll
    for (int r = 0; r < NR; ++r) { const h16x4* zr = (const h16x4*)(z + (size_t)(m0 + r * stride) * D) + lane; s[r] = 0.f;
#pragma unroll
        for (int j = 0; j < 4; ++j) v[r][j] = __builtin_convertvector(zr[64 * j], f32x4); }
#pragma unroll
    for (int r = 0; r < NR; ++r)
#pragma unroll
        for (int j = 0; j < 4; ++j) s[r] += (v[r][j].x + v[r][j].y) + (v[r][j].z + v[r][j].w);
#pragma unroll
    for (int o = 1; o < 64; o <<= 1)
#pragma unroll
        for (int r = 0; r < NR; ++r) s[r] += __shfl_xor(s[r], o);
    float mean[NR], s2[NR];
#pragma unroll
    for (int r = 0; r < NR; ++r) { mean[r] = s[r] * (1.f / D); s2[r] = 0.f;
#pragma unroll
        for (int j = 0; j < 4; ++j) { v[r][j] = v[r][j] - mean[r]; s2[r] += (v[r][j].x * v[r][j].x + v[r][j].y * v[r][j].y) + (v[r][j].z * v[r][j].z + v[r][j].w * v[r][j].w); } }
#pragma unroll
    for (int o = 1; o < 64; o <<= 1)
#pragma unroll
        for (int r = 0; r < NR; ++r) s2[r] += __shfl_xor(s2[r], o);
#pragma unroll
    for (int r = 0; r < NR; ++r) { const int m = m0 + r * stride; const float rstd = 1.f / sqrtf(s2[r] * (1.f / D) + LN_EPS);
        if (!final_out && lane == 0) *(f32x2*)(st + 2 * (size_t)m) = (f32x2){mean[r], rstd};
        f32x4* xr = (f32x4*)(outf + (size_t)m * D) + lane; unsigned long long* o8 = (unsigned long long*)(xb + (size_t)m * D) + lane;
#pragma unroll
        for (int j = 0; j < 4; ++j) { const f32x4 gg = ((const f32x4*)g)[lane + 64 * j], bb = ((const f32x4*)b)[lane + 64 * j];
            const f32x4 y = v[r][j] * rstd * gg + bb;
            if (final_out) xr[64 * j] = y;
            else o8[64 * j] = (unsigned long long)pk2(y.x, y.y) | ((unsigned long long)pk2(y.z, y.w) << 32); } }
}

__device__ __forceinline__ int t5_bucket(int rel) {
    const int n = rel < 0 ? -rel : rel;
    int b = n < 8 ? n : 8 + (n >= 15) + (n >= 27) + (n >= 50) + (n >= 91) + (n >= 166) + (n >= 305) + (n >= 559);
    return b + (rel > 0 ? 16 : 0);
}

#define MFMA16(a, b, c) __builtin_amdgcn_mfma_f32_16x16x32_bf16(a, b, c, 0, 0, 0)
typedef short v4i16_t __attribute__((ext_vector_type(4)));
__device__ __forceinline__ v4i16_t vtr(const LAS unsigned char* p) { return __builtin_amdgcn_ds_read_tr16_b64_v4i16((LAS v4i16_t*)p); }

constexpr int AT_KS = 0, AT_VT = 27648, AT_BIAS = 27648 + 30720, AT_HALF = 58944;
struct AttnIdx { int hh, m0, dsh, n, r, nb; };
__device__ __forceinline__ AttnIdx attn_index(int P, int hw) {
    AttnIdx X; X.hh = 2 * (P >> 9) + hw; const int tq = P & 511; int S, lt;
    if (tq < 256) { X.m0 = (tq >> 7) * 8192; lt = tq & 127; S = 8192; } else { const int t = tq - 256; X.m0 = 16384 + (t >> 5) * 2048; lt = t & 31; S = 2048; }
    X.dsh = 2 * (X.hh >> 2); X.n = S >> X.dsh; const int nblk = X.n >> 6; X.r = lt / nblk; X.nb = lt % nblk; return X;
}
__device__ __forceinline__ void attn_load(const Params& p, const AttnIdx& X, int t2, int wq, int fr, int fq, v4u (&kv)[6], v4u (&vv)[6], bf16x8 (&qa)[2], float& bv) {
    const bf16* QKVX = (const bf16*)(p.ws + WS_QKVX); const int d = 1 << X.dsh;
#pragma unroll
    for (int k = 0; k < 6; ++k) { const int c = k * 256 + t2;
        { const int key = c >> 3, d8 = c & 7, jk = X.nb * 64 - 64 + key; kv[k] = (v4u){0u, 0u, 0u, 0u};
          if (jk >= 0 && jk < X.n) kv[k] = *(const v4u*)(QKVX + (size_t)(X.m0 + jk * d + X.r) * 3072 + 768 + X.hh * 64 + d8 * 8); }
        { const int key = c >> 3, d8 = c & 7, jk = X.nb * 64 - 64 + key; vv[k] = (v4u){0u, 0u, 0u, 0u};
          if (jk >= 0 && jk < X.n) vv[k] = *(const v4u*)(QKVX + (size_t)(X.m0 + jk * d + X.r) * 3072 + 1536 + X.hh * 64 + d8 * 8); } }
    bv = 0.f; if (t2 < 129) bv = p.rel_bias[t5_bucket((t2 - 64) * d) * 12 + X.hh];
    const bf16* qp = QKVX + (size_t)(X.m0 + (X.nb * 64 + 16 * wq + fr) * d + X.r) * 3072 + X.hh * 64 + 8 * fq;
    qa[0] = *(const bf16x8*)qp; qa[1] = *(const bf16x8*)(qp + 32);
}
__device__ __forceinline__ void attn_phase(const Params& p, LAS unsigned char* lds, const int bx, const int G, const int tid) {
    const int hw = tid >> 8, t2 = tid & 255, lane = tid & 63, wq = (tid >> 6) & 3, fr = lane & 15, fq = lane >> 4;
    LAS unsigned char* L = lds + hw * AT_HALF;
    bf16* QKVX = (bf16*)(p.ws + WS_QKVX); float* LSE = (float*)(p.ws + WS_LSE);
    v4u kv[6], vv[6]; bf16x8 qn[2]; float bv;
    int it = (G == 256) ? (bx & 7) * 32 + (bx >> 3) : bx;
    if (it < 3072) { const AttnIdx X0 = attn_index(it, hw); attn_load(p, X0, t2, wq, fr, fq, kv, vv, qn, bv); }
    for (; it < 3072; it += G) {
        const AttnIdx X = attn_index(it, hw); const int d = 1 << X.dsh;
#pragma unroll
        for (int k = 0; k < 6; ++k) { const int c = k * 256 + t2;
            *(LAS v4u*)(L + AT_KS + (c >> 3) * 144 + (c & 7) * 16) = kv[k];
            *(LAS v4u*)(L + AT_VT + (c >> 3) * 160 + (c & 7) * 16) = vv[k]; }
        if (t2 < 129) ((LAS float*)(L + AT_BIAS))[t2] = bv;
        const bf16x8 q0 = qn[0], q1 = qn[1];
        __syncthreads();
        if (it + G < 3072) { const AttnIdx X1 = attn_index(it + G, hw); attn_load(p, X1, t2, wq, fr, fq, kv, vv, qn, bv); }
        f32x4 st[12];
#pragma unroll
        for (int ct = 0; ct < 12; ++ct) { st[ct] = (f32x4){0.f, 0.f, 0.f, 0.f};
            const bf16x8 k0 = *(const LAS bf16x8*)(L + AT_KS + (16 * ct + fr) * 144 + (8 * fq) * 2), k1 = *(const LAS bf16x8*)(L + AT_KS + (16 * ct + fr) * 144 + (32 + 8 * fq) * 2);
            st[ct] = MFMA16(k0, q0, st[ct]); st[ct] = MFMA16(k1, q1, st[ct]); }
        const int qi = 16 * wq + fr; float mx = -3e38f;
#pragma unroll
        for (int ct = 0; ct < 12; ++ct)
#pragma unroll
            for (int e = 0; e < 4; ++e) { const int u = 16 * ct + 4 * fq + e, jk = X.nb * 64 - 64 + u, dl = u - 64 - qi; const bool ok = jk >= 0 && jk < X.n && dl >= -64 && dl <= 64;
                const float b = ((const LAS float*)(L + AT_BIAS))[ok ? dl + 64 : 0]; const float sv = ok ? st[ct][e] + b : -1e30f; st[ct][e] = sv; mx = fmaxf(mx, sv); }
        mx = fmaxf(mx, __shfl_xor(mx, 16)); mx = fmaxf(mx, __shfl_xor(mx, 32));
        float sm = 0.f;
#pragma unroll
        for (int ct = 0; ct < 12; ++ct)
#pragma unroll
            for (int e = 0; e < 4; ++e) { const float pv = __expf(st[ct][e] - mx); st[ct][e] = pv; sm += pv; }
        sm += __shfl_xor(sm, 16); sm += __shfl_xor(sm, 32);
        f32x4 ot[4];
#pragma unroll
        for (int dt = 0; dt < 4; ++dt) ot[dt] = (f32x4){0.f, 0.f, 0.f, 0.f};
#pragma unroll
        for (int ks = 0; ks < 6; ++ks) { v4u pw; pw.x = pk2(st[2 * ks][0], st[2 * ks][1]); pw.y = pk2(st[2 * ks][2], st[2 * ks][3]); pw.z = pk2(st[2 * ks + 1][0], st[2 * ks + 1][1]); pw.w = pk2(st[2 * ks + 1][2], st[2 * ks + 1][3]);
            const bf16x8 pb = __builtin_bit_cast(bf16x8, pw);
#pragma unroll
            for (int dt = 0; dt < 4; ++dt) { const LAS unsigned char* vr = L + AT_VT + (32 * ks + 4 * fq + (fr >> 2)) * 160 + (16 * dt + 4 * (fr & 3)) * 2;
                const v4i16_t lo = vtr(vr), hi = vtr(vr + 16 * 160);
                ot[dt] = MFMA16(__builtin_shufflevector(lo, hi, 0, 1, 2, 3, 4, 5, 6, 7), pb, ot[dt]); } }
        { const size_t m = (size_t)(X.m0 + (X.nb * 64 + qi) * d + X.r); const float inv = 1.f / sm;
#pragma unroll
          for (int dt = 0; dt < 4; ++dt) { unsigned long long w = (unsigned long long)pk2(ot[dt][0] * inv, ot[dt][1] * inv) | ((unsigned long long)pk2(ot[dt][2] * inv, ot[dt][3] * inv) << 32);
              *(unsigned long long*)(QKVX + m * 3072 + X.hh * 64 + 16 * dt + 4 * fq) = w; }
          if (fq == 0) LSE[m * 12 + X.hh] = mx + __logf(sm); }
        __syncthreads();
    }
}

constexpr int MA_KS = 0, MA_VT = 69632;
static_assert(MA_VT + 256 * 288 <= LDS_BYTES - 64, "memattn LDS map");
__device__ __forceinline__ void memattn_group(const Params& p, LAS unsigned char* lds, int grp, const int tid) {
    const int lane = tid & 63, w = tid >> 6, fr = lane & 15, fq = lane >> 4;
    bf16* QM = (bf16*)(p.ws + WS_QM); const bf16* MKV = (const bf16*)(p.ws + WS_MEMKV);
    int bi, h, mg;
    if (grp < 128) { bi = grp >> 6; h = (grp >> 4) & 3; mg = bi * 8192 + (grp & 15) * 512; }
    else { const int g2 = grp - 128; bi = 2 + (g2 >> 4); h = (g2 >> 2) & 3; mg = 16384 + (g2 >> 4) * 2048 + (g2 & 3) * 512; }
    const bf16* kbase = MKV + (size_t)(bi * 256) * 1024 + h * 128; const bf16* vbase = kbase + 512;
    { v4u kr[8], vr8[8];
#pragma unroll
      for (int k = 0; k < 8; ++k) { const int c = k * 512 + tid; kr[k] = *(const v4u*)(kbase + (size_t)(c >> 4) * 1024 + (c & 15) * 8); vr8[k] = *(const v4u*)(vbase + (size_t)(c >> 4) * 1024 + (c & 15) * 8); }
#pragma unroll
      for (int k = 0; k < 8; ++k) { const int c = k * 512 + tid; *(LAS v4u*)(lds + MA_KS + (c >> 4) * 272 + (c & 15) * 16) = kr[k];
          *(LAS v4u*)(lds + MA_VT + (c >> 4) * 288 + (c & 15) * 16) = vr8[k]; } }
    bf16x8 qn[4];
    { const bf16* qp = QM + (size_t)(mg + 16 * w + fr) * 512 + h * 128 + 8 * fq;
#pragma unroll
      for (int ks = 0; ks < 4; ++ks) qn[ks] = *(const bf16x8*)(qp + 32 * ks); }
    __syncthreads();
#pragma nounroll
    for (int j = 0; j < 4; ++j) {
        asm volatile("" ::: "memory");
        const int m0 = mg + j * 128;
        bf16x8 qa[4];
#pragma unroll
        for (int ks = 0; ks < 4; ++ks) qa[ks] = qn[ks];
        if (j < 3) { const bf16* qp = QM + (size_t)(m0 + 128 + 16 * w + fr) * 512 + h * 128 + 8 * fq;
#pragma unroll
            for (int ks = 0; ks < 4; ++ks) qn[ks] = *(const bf16x8*)(qp + 32 * ks); }
        f32x4 st[16]; float mx = -3e38f;
#pragma unroll
        for (int ct = 0; ct < 16; ++ct) { st[ct] = (f32x4){0.f, 0.f, 0.f, 0.f};
#pragma unroll
            for (int ks = 0; ks < 4; ++ks) { const bf16x8 kb = *(const LAS bf16x8*)(lds + MA_KS + (16 * ct + fr) * 272 + (32 * ks + 8 * fq) * 2); st[ct] = MFMA16(kb, qa[ks], st[ct]); }
            mx = fmaxf(fmaxf(mx, fmaxf(st[ct][0], st[ct][1])), fmaxf(st[ct][2], st[ct][3])); }
        mx = fmaxf(mx, __shfl_xor(mx, 16)); mx = fmaxf(mx, __shfl_xor(mx, 32));
        float sm = 0.f;
#pragma unroll
        for (int ct = 0; ct < 16; ++ct)
#pragma unroll
            for (int e = 0; e < 4; ++e) { const float pv = __expf(st[ct][e] - mx); st[ct][e] = pv; sm += pv; }
        sm += __shfl_xor(sm, 16); sm += __shfl_xor(sm, 32);
        f32x4 ot[8];
#pragma unroll
        for (int dt = 0; dt < 8; ++dt) ot[dt] = (f32x4){0.f, 0.f, 0.f, 0.f};
#pragma unroll
        for (int ks = 0; ks < 8; ++ks) { v4u pw; pw.x = pk2(st[2 * ks][0], st[2 * ks][1]); pw.y = pk2(st[2 * ks][2], st[2 * ks][3]); pw.z = pk2(st[2 * ks + 1][0], st[2 * ks + 1][1]); pw.w = pk2(st[2 * ks + 1][2], st[2 * ks + 1][3]);
            const bf16x8 pb = __builtin_bit_cast(bf16x8, pw);
#pragma unroll
            for (int dt = 0; dt < 8; ++dt) { const LAS unsigned char* vr = lds + MA_VT + (32 * ks + 4 * fq + (fr >> 2)) * 288 + (16 * dt + 4 * (fr & 3)) * 2;
                const v4i16_t lo = vtr(vr), hi = vtr(vr + 16 * 288);
                ot[dt] = MFMA16(__builtin_shufflevector(lo, hi, 0, 1, 2, 3, 4, 5, 6, 7), pb, ot[dt]); } }
        { const size_t m = (size_t)(m0 + 16 * w + fr); const float inv = 1.f / sm;
#pragma unroll
          for (int dt = 0; dt < 8; ++dt) { unsigned long long wv = (unsigned long long)pk2(ot[dt][0] * inv, ot[dt][1] * inv) | ((unsigned long long)pk2(ot[dt][2] * inv, ot[dt][3] * inv) << 32);
              *(unsigned long long*)(QM + m * 512 + h * 128 + 16 * dt + 4 * fq) = wv; } }
    }
    __syncthreads();
}

constexpr int LCH = 128, NCH = T / LCH;
constexpr int LR_XR = 0, LR_WG = 18944, LR_CW = LR_WG + 36864, LR_CB = LR_CW + 1024, LR_GC = LR_CB + 256, LR_SEG = LR_GC + 1536, LR_HB = LR_SEG + 8192, LR_END = LR_HB + 65536;
static_assert(LR_END <= LDS_BYTES - 64, "LRU LDS map");
constexpr size_t WS_C8 = 65536, WS_STATS = 262144; static_assert(WS_STATS == 262144, "EpiResid hard-codes the stats offset");
__device__ __forceinline__ float em1_small(float x) {
    float q = 1.f + x * (1.f / 7.f); q = 1.f + x * (1.f / 6.f) * q; q = 1.f + x * 0.2f * q; q = 1.f + x * 0.25f * q; q = 1.f + x * (1.f / 3.f) * q; q = 1.f + x * 0.5f * q; return x * q;
}
__device__ __forceinline__ void lru_setup(const Params& p, int L, LAS unsigned char* lds, int jb, const int tid) {
    const bf16* WL = (const bf16*)(p.ws + WS_WT) + WT_LRU;
#pragma unroll
    for (int k = 0; k < 4; ++k) { const int c = k * NTHR + tid, row = c >> 3, d8 = c & 7, dir = row >> 7, g = (row >> 6) & 1, o = row & 63;
        *(LAS v4u*)(lds + LR_WG + row * 144 + d8 * 16) = *(const v4u*)(WL + (size_t)((dir * 12 + jb) * 2 + g) * 4096 + o * 64 + d8 * 8); }
    if (tid < 256) ((LAS float*)(lds + LR_CW))[tid] = p.conv_w[(size_t)L * 4 * 768 + (tid >> 6) * 768 + jb * 64 + (tid & 63)];
    if (tid < 64) ((LAS float*)(lds + LR_CB))[tid] = p.conv_b[(size_t)L * 768 + jb * 64 + tid];
    if (tid < 384) { const int dir = tid / 192, q = (tid % 192) >> 6, ch = tid & 63; const size_t gi = (size_t)(L * 2 + dir) * 768 + jb * 64 + ch;
        ((LAS float*)(lds + LR_GC))[tid] = q == 0 ? p.lru_ba[gi] : (q == 1 ? p.lru_bx[gi] : ((const float*)(p.ws + WS_C8))[dir * 768 + jb * 64 + ch]); }
    __syncthreads();
}
__device__ __forceinline__ void lru_load(const Params& p, int ci, int jb, const int tid, v4u (&xv)[3]) {
    const int t0 = ci * LCH;
    int cs, S;
    if (ci < 128) { cs = ci & 63; S = 8192; } else { cs = (ci - 128) & 15; S = 2048; }
    const bf16* QKVX = (const bf16*)(p.ws + WS_QKVX);
#pragma unroll
    for (int k = 0; k < 3; ++k) { const int c = k * NTHR + tid, rr = c >> 3, d8 = c & 7, sq = cs * LCH + rr - 1; xv[k] = (v4u){0u, 0u, 0u, 0u};
        if (c < 131 * 8 && sq >= 0 && sq < S) xv[k] = *(const v4u*)(QKVX + (size_t)(t0 + rr - 1) * 3072 + 2304 + jb * 64 + d8 * 8); }
}
template <bool PHASE_B>
__device__ __forceinline__ void lru_item(const Params& p, LAS unsigned char* lds, int ci, int ci_next, int jb, const int tid, v4u (&xvn)[3]) {
    const int lane = tid & 63, rt = tid >> 6, fr = lane & 15, fq = lane >> 4;
    const int t0 = ci * LCH;
#pragma unroll
    for (int k = 0; k < 3; ++k) { const int c = k * NTHR + tid, rr = c >> 3, d8 = c & 7; if (c < 131 * 8) *(LAS v4u*)(lds + LR_XR + rr * 144 + d8 * 16) = xvn[k]; }
    float cin[2][4]; v4u gv[2];
    __syncthreads();
    if (ci_next >= 0) lru_load(p, ci_next, jb, tid, xvn);
    const LAS float* CW = (const LAS float*)(lds + LR_CW); const LAS float* CB = (const LAS float*)(lds + LR_CB); const LAS float* GC = (const LAS float*)(lds + LR_GC);
    bf16x8 af[2];
#pragma unroll
    for (int ks = 0; ks < 2; ++ks) { const int cb0 = 32 * ks + 8 * fq;
        f32x4 s0 = *(const LAS f32x4*)(CB + cb0), s1 = *(const LAS f32x4*)(CB + cb0 + 4);
#pragma unroll
        for (int tap = 0; tap < 4; ++tap) { const v4u v = *(const LAS v4u*)(lds + LR_XR + (16 * rt + fr + tap) * 144 + cb0 * 2);
            const f32x4 w0 = *(const LAS f32x4*)(CW + tap * 64 + cb0), w1 = *(const LAS f32x4*)(CW + tap * 64 + cb0 + 4);
            s0 += (f32x4){bflo(v.x), bfhi(v.x), bflo(v.y), bfhi(v.y)} * w0; s1 += (f32x4){bflo(v.z), bfhi(v.z), bflo(v.w), bfhi(v.w)} * w1; }
        v4u o; o.x = pk2(s0[0], s0[1]); o.y = pk2(s0[2], s0[3]); o.z = pk2(s1[0], s1[1]); o.w = pk2(s1[2], s1[3]);
        af[ks] = __builtin_bit_cast(bf16x8, o); }
    float xc[4][4];
#pragma unroll
    for (int ct = 0; ct < 4; ++ct) { const int ch = 16 * ct + fr; float xr7[7];
#pragma unroll
        for (int j = 0; j < 7; ++j) xr7[j] = __builtin_bit_cast(float, (unsigned)(*(const LAS bf16*)(lds + LR_XR + (16 * rt + 4 * fq + j) * 144 + ch * 2)) << 16);
        const float w0 = CW[ch], w1 = CW[64 + ch], w2 = CW[128 + ch], w3 = CW[192 + ch], b = CB[ch];
#pragma unroll
        for (int e = 0; e < 4; ++e) xc[ct][e] = b + xr7[e] * w0 + xr7[e + 1] * w1 + xr7[e + 2] * w2 + xr7[e + 3] * w3; }
    float av[2][4][4], uv[2][4][4], pA[2][4], pH[2][4];
#pragma unroll
    for (int dir = 0; dir < 2; ++dir) {
#pragma unroll
        for (int ct = 0; ct < 4; ++ct) {
            f32x4 ga = (f32x4){0.f, 0.f, 0.f, 0.f}, gx = (f32x4){0.f, 0.f, 0.f, 0.f};
#pragma unroll
            for (int ks = 0; ks < 2; ++ks) {
                const bf16x8 wa = *(const LAS bf16x8*)(lds + LR_WG + ((dir * 2 + 0) * 64 + 16 * ct + fr) * 144 + (32 * ks + 8 * fq) * 2);
                const bf16x8 wx = *(const LAS bf16x8*)(lds + LR_WG + ((dir * 2 + 1) * 64 + 16 * ct + fr) * 144 + (32 * ks + 8 * fq) * 2);
                ga = MFMA16(af[ks], wa, ga); gx = MFMA16(af[ks], wx, gx); }
            const int ch = 16 * ct + fr; const float bav = GC[(dir * 3 + 0) * 64 + ch], bxv = GC[(dir * 3 + 1) * 64 + ch], c8 = GC[(dir * 3 + 2) * 64 + ch];
            float Al = 1.f, Hl = 0.f;
#pragma unroll
            for (int ee = 0; ee < 4; ++ee) { const int e = dir ? 3 - ee : ee;
                const float r = __builtin_amdgcn_rcpf(1.f + __expf(-(ga[e] + bav))), ig = __builtin_amdgcn_rcpf(1.f + __expf(-(gx[e] + bxv)));
                const float la = -c8 * r; const float a = __expf(la); const float u = __builtin_amdgcn_sqrtf((1.f - a) * (1.f + a)) * (ig * xc[ct][e]);
                av[dir][ct][e] = a; uv[dir][ct][e] = u; Hl = a * Hl + u; Al *= a; }
            const int o = dir ? 3 - fq : fq; float PA = 1.f, PH = 0.f, TA = 1.f, TH = 0.f;
#pragma unroll
            for (int q = 0; q < 4; ++q) { const int src = (dir ? 3 - q : q) * 16 + fr; const float Aq = __shfl(Al, src), Hq = __shfl(Hl, src);
                const float nPH = Aq * PH + Hq, nPA = PA * Aq; PH = (q < o) ? nPH : PH; PA = (q < o) ? nPA : PA; TH = Aq * TH + Hq; TA *= Aq; }
            pA[dir][ct] = PA; pH[dir][ct] = PH;
            ((LAS f32x2*)(lds + LR_SEG))[(dir * 8 + rt) * 64 + ch] = (f32x2){TA, TH};
        }
    }
    if constexpr (PHASE_B) {
#pragma unroll
        for (int dir = 0; dir < 2; ++dir)
#pragma unroll
            for (int ct = 0; ct < 4; ++ct) cin[dir][ct] = ((const float*)(p.ws + WS_CIN))[(size_t)(ci * 2 + dir) * 768 + jb * 64 + 16 * ct + fr];
        const bf16* gp = (const bf16*)(p.ws + WS_GR) + (size_t)(t0 + (tid >> 2)) * 768 + jb * 64 + (tid & 3) * 16;
        gv[0] = *(const v4u*)gp; gv[1] = *(const v4u*)(gp + 8);
    }
    __syncthreads();
    if constexpr (!PHASE_B) {
        if (tid < 128) { const int dir = tid >> 6, ch = tid & 63; float A = 1.f, H = 0.f;
#pragma unroll
            for (int q = 0; q < 8; ++q) { const f32x2 sh = ((const LAS f32x2*)(lds + LR_SEG))[(dir * 8 + (dir ? 7 - q : q)) * 64 + ch]; H = sh.x * H + sh.y; A *= sh.x; }
            ((f32x2*)(p.ws + WS_CAR))[(size_t)(ci * 2 + dir) * 768 + jb * 64 + ch] = (f32x2){A, H}; }
    } else {
#pragma unroll
        for (int dir = 0; dir < 2; ++dir) { const int ot = dir ? 7 - rt : rt;
#pragma unroll
            for (int ct = 0; ct < 4; ++ct) { const int ch = 16 * ct + fr; float h = cin[dir][ct];
#pragma unroll
                for (int q = 0; q < 7; ++q) { const f32x2 sh = ((const LAS f32x2*)(lds + LR_SEG))[(dir * 8 + (dir ? 7 - q : q)) * 64 + ch]; const float nh = sh.x * h + sh.y; h = (q < ot) ? nh : h; }
                h = pA[dir][ct] * h + pH[dir][ct];
#pragma unroll
                for (int ee = 0; ee < 4; ++ee) { const int e = dir ? 3 - ee : ee; h = av[dir][ct][e] * h + uv[dir][ct][e];
                    ((LAS float*)(lds + LR_HB))[(dir * LCH + 16 * rt + 4 * fq + e) * 64 + ch] = h; } } }
        __syncthreads();
        { const int t = tid >> 2, c0 = (tid & 3) * 16; bf16* gp = (bf16*)(p.ws + WS_GR) + (size_t)(t0 + t) * 768 + jb * 64 + c0;
          const LAS float* H0 = (const LAS float*)(lds + LR_HB) + t * 64 + c0; const LAS float* H1 = H0 + LCH * 64;
#pragma unroll
          for (int hf = 0; hf < 2; ++hf) { const f32x4 a0 = *(const LAS f32x4*)(H0 + 8 * hf), a1 = *(const LAS f32x4*)(H0 + 8 * hf + 4), b0 = *(const LAS f32x4*)(H1 + 8 * hf), b1 = *(const LAS f32x4*)(H1 + 8 * hf + 4);
              const v4u g = gv[hf]; v4u o;
              o.x = pk2(bflo(g.x) * (a0[0] + b0[0]), bfhi(g.x) * (a0[1] + b0[1])); o.y = pk2(bflo(g.y) * (a0[2] + b0[2]), bfhi(g.y) * (a0[3] + b0[3]));
              o.z = pk2(bflo(g.z) * (a1[0] + b1[0]), bfhi(g.z) * (a1[1] + b1[1])); o.w = pk2(bflo(g.w) * (a1[2] + b1[2]), bfhi(g.w) * (a1[3] + b1[3]));
              *(v4u*)(gp + 8 * hf) = o; } }
    }
}

__device__ __forceinline__ void lru_carry(const Params& p, int gt) {
    if (gt >= 10 * 1536) return;
    const int seq = gt / 1536, rem = gt % 1536, dir = rem / 768, ch = rem % 768;
    int c0, nc; if (seq < 2) { c0 = seq * 64; nc = 64; } else { c0 = 128 + (seq - 2) * 16; nc = 16; }
    const f32x2* CAR = (const f32x2*)(p.ws + WS_CAR); float* CIN = (float*)(p.ws + WS_CIN);
    float h = 0.f;
    for (int k = 0; k < nc; k += 8) { f32x2 v[8];
#pragma unroll
        for (int j = 0; j < 8; ++j) { const int c = dir ? c0 + nc - 1 - (k + j) : c0 + k + j; v[j] = CAR[(size_t)(c * 2 + dir) * 768 + ch]; }
#pragma unroll
        for (int j = 0; j < 8; ++j) { const int c = dir ? c0 + nc - 1 - (k + j) : c0 + k + j; CIN[(size_t)(c * 2 + dir) * 768 + ch] = h; h = v[j].x * h + v[j].y; } }
}
__device__ __forceinline__ void attn_merge(const Params& p, int gt, int ngt) {
    const bf16* QKVX = (const bf16*)(p.ws + WS_QKVX); const float* LSE = (const float*)(p.ws + WS_LSE); bf16* AT = (bf16*)(p.ws + WS_ATTN);
    for (int idx = gt; idx < T * 32; idx += ngt) { const int m = idx >> 5, c8 = idx & 31, h = c8 >> 3;
        const float l0 = LSE[(size_t)m * 12 + h], l1 = LSE[(size_t)m * 12 + 4 + h], l2 = LSE[(size_t)m * 12 + 8 + h];
        const float mx = fmaxf(l0, fmaxf(l1, l2)); float w0 = __expf(l0 - mx), w1 = __expf(l1 - mx), w2 = __expf(l2 - mx); const float inv = 1.f / (w0 + w1 + w2); w0 *= inv; w1 *= inv; w2 *= inv;
        const bf16* o = QKVX + (size_t)m * 3072 + c8 * 8;
        const v4u a = *(const v4u*)o, b = *(const v4u*)(o + 256), c = *(const v4u*)(o + 512);
        v4u r;
        r.x = pk2(w0 * bflo(a.x) + w1 * bflo(b.x) + w2 * bflo(c.x), w0 * bfhi(a.x) + w1 * bfhi(b.x) + w2 * bfhi(c.x));
        r.y = pk2(w0 * bflo(a.y) + w1 * bflo(b.y) + w2 * bflo(c.y), w0 * bfhi(a.y) + w1 * bfhi(b.y) + w2 * bfhi(c.y));
        r.z = pk2(w0 * bflo(a.z) + w1 * bflo(b.z) + w2 * bflo(c.z), w0 * bfhi(a.z) + w1 * bfhi(b.z) + w2 * bfhi(c.z));
        r.w = pk2(w0 * bflo(a.w) + w1 * bflo(b.w) + w2 * bflo(c.w), w0 * bfhi(a.w) + w1 * bfhi(b.w) + w2 * bfhi(c.w));
        *(v4u*)(AT + (size_t)m * 256 + c8 * 8) = r; }
}


#define XB_TMO      128
#define XB_XCNT(j)  (256  + 64 * (j))
#define XB_XSUB(j)  (1280 + 64 * (j))
#define XB_XGEN(j)  (2304 + 64 * (j))
#define XB_TOP      3328
#define XB_TOPGEN   3392
#define XCD_BAR_WORDS 3456
#define XB_SPIN_CAP (1u << 18)
__device__ __forceinline__ unsigned xb_ld(unsigned* p)              { return __hip_atomic_load(p, __ATOMIC_RELAXED, __HIP_MEMORY_SCOPE_AGENT); }
__device__ __forceinline__ unsigned xb_add(unsigned* p, unsigned v) { return __hip_atomic_fetch_add(p, v, __ATOMIC_RELAXED, __HIP_MEMORY_SCOPE_AGENT); }
__device__ __forceinline__ unsigned xb_xcc_id() { return (unsigned)__builtin_amdgcn_s_getreg((3 << 11) | 20) & 0xFu; }
#define XB_SPIN(cond, bar) do { unsigned _sp = 0; while (cond) { __builtin_amdgcn_s_sleep(1); \
    if ((++_sp & 255u) == 0u) { if (xb_ld(&(bar)[XB_TMO])) break; if (_sp > XB_SPIN_CAP) { atomicAdd(&(bar)[XB_TMO], 1u); break; } } } } while (0)
struct XcdBarrier { unsigned* bar; unsigned x; volatile LAS unsigned* st; };
__device__ __forceinline__ XcdBarrier xcd_barrier_post(unsigned* bar, volatile LAS unsigned* st) {
    XcdBarrier b; b.bar = bar; b.x = xb_xcc_id(); b.st = st;
    if (threadIdx.x == 0) (void)xb_add(&bar[XB_XCNT(b.x)], 1u);
    return b;
}
__device__ __forceinline__ void xcd_barrier_complete(unsigned* bar, unsigned x, unsigned& nloc, unsigned& nx) {
    const unsigned G = gridDim.x * gridDim.y * gridDim.z;
    unsigned sum, cnt, mine, sp = 0u;
    for (;;) {
        sum = 0u; cnt = 0u; mine = 0u;
#pragma unroll
        for (unsigned j = 0; j < 16; ++j) { const unsigned c = xb_ld(&bar[XB_XCNT(j)]); sum += c; cnt += (c > 0u) ? 1u : 0u; mine = (j == x) ? c : mine; }
        if (sum == G) break;
        __builtin_amdgcn_s_sleep(1);
        if ((++sp & 255u) == 0u) { if (xb_ld(&bar[XB_TMO])) break; if (sp > XB_SPIN_CAP) { atomicAdd(&bar[XB_TMO], 1u); break; } }
    }
    nloc = mine > 0u ? mine : 1u; nx = cnt > 0u ? cnt : 1u;
}
__device__ __forceinline__ void xcd_barrier(const XcdBarrier& b) {
    asm volatile("s_waitcnt vmcnt(0)" ::: "memory");
    __syncthreads();
    if (threadIdx.x == 0) {
        unsigned* bar = b.bar;
        __builtin_amdgcn_s_waitcnt(0);
        unsigned nloc = b.st[0], nx = b.st[1];
        if (nloc == 0u) { xcd_barrier_complete(bar, b.x, nloc, nx); b.st[0] = nloc; b.st[1] = nx; }
        const unsigned old = xb_add(&bar[XB_XSUB(b.x)], 1u);
        const unsigned gen = old / nloc;
        if (old + 1u == (gen + 1u) * nloc) {
            __builtin_amdgcn_fence(__ATOMIC_RELEASE, "agent");
            asm volatile("s_waitcnt vmcnt(0)" ::: "memory");
            const unsigned og = xb_add(&bar[XB_TOP], 1u);
            const unsigned tg = og / nx;
            if (og + 1u == (tg + 1u) * nx) xb_add(&bar[XB_TOPGEN], 1u);
            else XB_SPIN(xb_ld(&bar[XB_TOPGEN]) == tg, bar);
            __builtin_amdgcn_fence(__ATOMIC_ACQUIRE, "agent");
            xb_add(&bar[XB_XGEN(b.x)], 1u);
            asm volatile("s_waitcnt vmcnt(0)" ::: "memory");
        } else {
            XB_SPIN(xb_ld(&bar[XB_XGEN(b.x)]) == gen, bar);
            __builtin_amdgcn_fence(__ATOMIC_ACQUIRE, "agent");
            asm volatile("s_waitcnt vmcnt(0)" ::: "memory");
        }
    }
    __syncthreads();
}
constexpr int MISC_OFF = LDS_BYTES - 64;

constexpr int N_PHASES = 27;
__global__ void __launch_bounds__(NTHR, 2) fwd_kernel(Params p) {
    extern __shared__ __attribute__((aligned(16))) unsigned char lds_raw[];
    LAS unsigned char* lds = (LAS unsigned char*)lds_raw;
#if MEGA
    if (threadIdx.x < 16) ((LAS unsigned*)(lds + MISC_OFF))[threadIdx.x] = 0u;
    __syncthreads();
    const XcdBarrier xbar = xcd_barrier_post((unsigned*)p.ws, (volatile LAS unsigned*)(lds + MISC_OFF));
#endif
    for (int ph = p.ph_lo; ph < p.ph_hi; ++ph) {
#if MEGA
        if (ph == p.ph_lo + 1) cg::this_grid().sync();
        else if (ph > p.ph_lo) xcd_barrier(xbar);
#endif
        int tid_ = threadIdx.x; asm volatile("" : "+v"(tid_));
        int G_ = gridDim.x, bx_ = blockIdx.x; asm volatile("" : "+s"(G_), "+s"(bx_));
        const int tid = tid_, lane = tid & 63, wave = __builtin_amdgcn_readfirstlane(tid >> 6);
        const int G = G_, bx = bx_, gw = bx * NWAVES + wave, ngw = G * NWAVES;
        unsigned char* ws_ = p.ws; asm volatile("" : "+s"(ws_));
        bf16* WT = (bf16*)(ws_ + WS_WT); bf16* XB = (bf16*)(ws_ + WS_XB); bf16* ACT = (bf16*)(ws_ + WS_ACT);
        if (ph == 0) {
            if (PHON(13)) {
            cvt_weights(p, 0, lds, gw, ngw, wave, lane);
            { int m = gw;
              for (; m + 3 * ngw < T; m += 4 * ngw) { f32x4 v[4][4];
#pragma unroll
                  for (int r = 0; r < 4; ++r) { const int mm = m + r * ngw; const f32x4* xr = (const f32x4*)(mm < 16384 ? p.x_prompt + (size_t)mm * D : p.x_sample + (size_t)(mm - 16384) * D) + lane;
#pragma unroll
                      for (int j = 0; j < 4; ++j) v[r][j] = xr[64 * j]; }
#pragma unroll
                  for (int r = 0; r < 4; ++r) { unsigned long long* o8 = (unsigned long long*)(XB + (size_t)(m + r * ngw) * D) + lane;
#pragma unroll
                      for (int j = 0; j < 4; ++j) o8[64 * j] = (unsigned long long)pk2(v[r][j].x, v[r][j].y) | ((unsigned long long)pk2(v[r][j].z, v[r][j].w) << 32); } }
              for (; m < T; m += ngw) cvt_row((m < 16384 ? p.x_prompt + (size_t)m * D : p.x_sample + (size_t)(m - 16384) * D), XB + (size_t)m * D, lane); }
            bf16* MB = (bf16*)(p.ws + WS_MEMB);
            for (int m = gw; m < 2560; m += ngw) cvt_row((m < 512 ? p.mem_prompt + (size_t)m * D : p.mem_sample + (size_t)(m - 512) * D), MB + (size_t)m * D, lane);
            }
            continue;
        }
        const int L = (ph - 1) / 13, k = (ph - 1) % 13;
        if (PHON(0) && (k == 0 || k == 10)) {
            pg8::Gemm g{XB, WT + (k == 0 ? WT_FFIN0 : WT_FFIN1), T, 2 * DFF, D, D}; pg8::StaticOrder S; S.init(T, 2 * DFF, G, bx);
            pg8::EpiSwiglu E{ACT};
            pg8::gemm_phase<pg8::EpiSwiglu, pg8::StaticOrder, true, true>(lds, g, S, E);
        } else if (PHON(1) && (k == 1 || k == 11)) {
            pg8::Gemm g{ACT, WT + (k == 1 ? WT_FFOUT0 : WT_FFOUT1), T, D, DFF, DFF}; pg8::StaticOrder S; S.init(T, D, G, bx);
            const bool first = (L == 0 && k == 1);
            const int lnl = (k == 1) ? (L - 1) * 3 + 2 : L * 3 + 1;
            pg8::EpiResid E{p.x_prompt, p.x_sample - (size_t)16384 * D, (_Float16*)(ws_ + WS_Z16), ALPHA, 0.5f, &p.ln_g, &p.ws, first ? -1 : lnl};
            pg8::gemm_phase<pg8::EpiResid, pg8::StaticOrder, true, true>(lds, g, S, E);
        } else if (PHON(2) && (k == 2 || k == 9 || k == 12)) {
            const int li = (k == 2) ? 0 : (k == 9 ? 1 : 2);
            const float* gg = p.ln_g + (size_t)(L * 3 + li) * D; const float* bb = p.ln_b + (size_t)(L * 3 + li) * D;
            const bool wbf = !(L == 1 && k == 12);
            { int m = gw;
              for (; m + 3 * ngw < T; m += 4 * ngw) ln_rows<4>((const _Float16*)(ws_ + WS_Z16), XB, (float*)(ws_ + WS_STATS), p.out, m, ngw, gg, bb, lane, !wbf);
              for (; m < T; m += ngw) ln_rows<1>((const _Float16*)(ws_ + WS_Z16), XB, (float*)(ws_ + WS_STATS), p.out, m, ngw, gg, bb, lane, !wbf); }
            if (k == 12 && L == 0) { __syncthreads(); cvt_weights(p, 1, lds, gw, ngw, wave, lane); }
        } else if (PHON(3) && k == 3) {
            pg8::Gemm g{XB, WT + WT_WIN, T, 4352, D, D}; pg8::StaticOrder S; S.init(T, 4352, G, bx);
            pg8::EpiWin E{(bf16*)(p.ws + WS_QKVX), (bf16*)(p.ws + WS_GR), (bf16*)(p.ws + WS_QM)};
            pg8::gemm_phase<pg8::EpiWin, pg8::StaticOrder, true, true>(lds, g, S, E);
            if (bx >= 128) {
                pg8::Gemm g2{(const bf16*)(p.ws + WS_MEMB), WT + WT_MEMKV, 2560, 1024, D, D}; pg8::StaticOrder S2; S2.init(2560, 1024, G, bx - 128);
                pg8::EpiBf16 E2{(bf16*)(p.ws + WS_MEMKV), 1024, 0};
                pg8::gemm_phase<pg8::EpiBf16, pg8::StaticOrder, true, true>(lds, g2, S2, E2);
            }
        } else if (PHON(4) && k == 4) {
            attn_phase(p, lds, bx, G, tid);
            for (int gq = bx; gq < 256; gq += G) memattn_group(p, lds, gq, tid);
            { const int jb = bx % 12, gi = bx / 12, gs = (G - jb + 11) / 12; lru_setup(p, L, lds, jb, tid);
              v4u xvn[3] = {(v4u){0u, 0u, 0u, 0u}, (v4u){0u, 0u, 0u, 0u}, (v4u){0u, 0u, 0u, 0u}};
              if (gi < NCH) lru_load(p, gi, jb, tid, xvn);
              for (int ci = gi; ci < NCH; ci += gs) lru_item<false>(p, lds, ci, (ci + gs < NCH) ? ci + gs : -1, jb, tid, xvn); }
        } else if (PHON(5) && k == 5) {
            lru_carry(p, bx * NTHR + tid);
            attn_merge(p, bx * NTHR + tid, G * NTHR);
        } else if (PHON(6) && k == 6) {
            { const int jb = bx % 12, gi = bx / 12, gs = (G - jb + 11) / 12; lru_setup(p, L, lds, jb, tid);
              v4u xvn[3] = {(v4u){0u, 0u, 0u, 0u}, (v4u){0u, 0u, 0u, 0u}, (v4u){0u, 0u, 0u, 0u}};
              if (gi < NCH) lru_load(p, gi, jb, tid, xvn);
              for (int ci = gi; ci < NCH; ci += gs) lru_item<true>(p, lds, ci, (ci + gs < NCH) ? ci + gs : -1, jb, tid, xvn); }
        } else if (PHON(7) && k == 7) {
            bf16* GB = (bf16*)(p.ws + WS_QKVX);
            { pg8::Gemm g{(const bf16*)(p.ws + WS_ATTN), WT + WT_BRA, T, 1024, 256, 256}; pg8::MgOrder S{G, bx, 0}; pg8::EpiBf16 E{GB, 3072, 0};
              pg8::gemm_phase<pg8::EpiBf16, pg8::MgOrder, true, true>(lds, g, S, E); }
            { pg8::Gemm g{(const bf16*)(p.ws + WS_GR), WT + WT_BRL, T, 1024, 768, 768}; pg8::MgOrder S{G, bx, 1}; pg8::EpiBf16 E{GB, 3072, 1024};
              pg8::gemm_phase<pg8::EpiBf16, pg8::MgOrder, true, true>(lds, g, S, E); }
            { pg8::Gemm g{(const bf16*)(p.ws + WS_QM), WT + WT_BRM, T, 1024, 512, 512}; pg8::MgOrder S{G, bx, 2}; pg8::EpiBf16 E{GB, 3072, 2048};
              pg8::gemm_phase<pg8::EpiBf16, pg8::MgOrder, true, true>(lds, g, S, E); }
            { pg8::Gemm g{XB, WT + WT_WIN + (size_t)4352 * 1024, T, 3072, D, D}; pg8::MgOrder S{G, bx, -1}; pg8::EpiGate E{GB, p.b_gate + (size_t)L * 3072};
              pg8::gemm_phase<pg8::EpiGate, pg8::MgOrder, true, true>(lds, g, S, E); }
        } else if (PHON(8) && k == 8) {
            pg8::Gemm g{(const bf16*)(p.ws + WS_QKVX), WT + WT_WOUT, T, D, D, 3072}; pg8::StaticOrder S; S.init(T, D, G, bx);
            pg8::EpiResid E{p.x_prompt, p.x_sample - (size_t)16384 * D, (_Float16*)(ws_ + WS_Z16), ALPHA, 1.0f, &p.ln_g, &p.ws, L * 3};
            pg8::gemm_phase<pg8::EpiResid, pg8::StaticOrder, true, true>(lds, g, S, E);
        }
    }
}

extern "C" void kernel_launch(void* const* d_in, const int* in_sizes, int n_in, void* d_out, int out_size, void* d_ws, size_t ws_size, hipStream_t stream) {
    static int grid = 0;
    if (grid == 0) {
        if (n_in != 23 || out_size != T * D || ws_size < WS_END) { fprintf(stderr, "kernel_launch: unexpected shapes (n_in %d out %d ws %zu)\n", n_in, out_size, ws_size); grid = -1; return; }
        int dev = 0, cus = 0, per_cu = 0;
        hipGetDevice(&dev); hipDeviceGetAttribute(&cus, hipDeviceAttributeMultiprocessorCount, dev);
        hipFuncSetAttribute((const void*)fwd_kernel, hipFuncAttributeMaxDynamicSharedMemorySize, LDS_BYTES);
        hipOccupancyMaxActiveBlocksPerMultiprocessor(&per_cu, (const void*)fwd_kernel, NTHR, LDS_BYTES);
        (void)hipGetLastError();
        if (per_cu < 1) per_cu = 1;
        grid = cus;
        if (grid > 256) grid = 256;
    }
    if (grid < 0) return;
    Params p{};
    const float** pf = (const float**)&p;
    for (int i = 0; i < 23; ++i) pf[i] = (const float*)d_in[i];
    p.out = (float*)d_out; p.ws = (unsigned char*)d_ws;
#if MEGA
    (void)hipMemsetAsync(d_ws, 0, 16384, stream);
    p.ph_lo = 0; p.ph_hi = N_PHASES;
    void* args[] = {&p};
    hipError_t e = hipLaunchCooperativeKernel((const void*)fwd_kernel, dim3(grid), dim3(NTHR), args, LDS_BYTES, stream);
    if (e != hipSuccess) fprintf(stderr, "cooperative launch failed: %s (grid %d)\n", hipGetErrorString(e), grid);
#else
    for (int ph = 0; ph < N_PHASES; ++ph) { p.ph_lo = ph; p.ph_hi = ph + 1; hipLaunchKernelGGL(fwd_kernel, dim3(grid), dim3(NTHR), LDS_BYTES, stream, p); }
#endif
}
```

```cpp
#include <hip/hip_runtime.h>
#include <hip/hip_cooperative_groups.h>
#include <cstdio>
#include <cstdint>
namespace cg = cooperative_groups;

#ifndef MEGA
#define MEGA 1
#endif
#ifndef PH_MASK
#define PH_MASK 0xFFFF
#endif
#define PHON(b) ((PH_MASK >> (b)) & 1)

namespace pg8 {
#define PG8_LAS __attribute__((address_space(3)))
typedef unsigned short bf16_t;
typedef short bf16x8 __attribute__((ext_vector_type(8)));
typedef float f32x4 __attribute__((ext_vector_type(4)));
typedef unsigned u32x4 __attribute__((ext_vector_type(4)));
typedef unsigned u32x2 __attribute__((ext_vector_type(2)));
typedef float f32x2 __attribute__((ext_vector_type(2)));
constexpr int BM = 256, BK = 64, HALF = 128, HTB = HALF * BK * 2, STAGE_BYTES = 8 * HTB, NXCD = 8, WGM = 8;

__host__ __device__ __forceinline__ int lds_byte(int r, int c) { const int st = (r >> 4) * 2 + (c >> 5), rr = r & 15, cc = c & 31, ob = rr * 64 + cc * 2; return st * 1024 + (ob ^ (((ob >> 9) & 1) << 5)); }
__host__ __device__ __forceinline__ void stage_rc(int b, int& R, int& C) { const int st = b / 1024, sb = b % 1024, swz = sb ^ (((sb >> 9) & 1) << 5); R = (st >> 1) * 16 + swz / 64; C = (st & 1) * 32 + (swz % 64) / 2; }
__host__ __device__ __forceinline__ int perm32(int rho) { const int n = rho >> 4, i = rho & 15; return 8 * (i >> 2) + 4 * n + (i & 3); }

struct Unit { int pm, pn; };
struct Gemm { const bf16_t* A; const bf16_t* Bt; int M, N, K; int lda; };

struct StaticOrder {
    int nM, nN, nwg, G, c;
    __device__ void init(int M, int N, int G_, int c_) { nM = M / BM; nN = N / BM; nwg = nM * nN; G = G_; c = c_; }
    __device__ bool next(int i, Unit& u) const {
        const long L = (long)i * G + c; if (L >= nwg) return false;
        int wgid = (int)L; { const int q = nwg / NXCD, r = nwg % NXCD, xcd = wgid % NXCD, off = wgid / NXCD; wgid = (xcd < r ? xcd * (q + 1) : r * (q + 1) + (xcd - r) * q) + off; }
        const int nig = WGM * nN, gid = wgid / nig, fm = gid * WGM, gsz = (nM - fm) < WGM ? (nM - fm) : WGM;
        u.pm = fm + ((wgid % nig) % gsz); u.pn = (wgid % nig) / gsz; return true;
    }
    __device__ __forceinline__ void a_ready(const Unit&) const {}
    __device__ __forceinline__ void done(const Unit&) const {}
};
struct MgOrder {
    int G, c, b;
    __device__ bool next(int i, Unit& u) const {
        const int ti = b < 0 ? i / 3 : i, br = b < 0 ? i - 3 * ti : 0; int pm, pn;
        if (G == 256) {
            if (ti >= 2) return false; const int x = c & 7, idx = c >> 3; pm = 8 * (ti * 8 + x) + (idx & 7); pn = idx >> 3;
        } else { const int L = c + ti * G; if (L >= 512) return false; pm = L >> 2; pn = L & 3; }
        u.pm = pm; u.pn = pn + 4 * br; return true;
    }
    __device__ __forceinline__ void a_ready(const Unit&) const {}
    __device__ __forceinline__ void done(const Unit&) const {}
};

__device__ __forceinline__ unsigned cvt_pk_bf16(float lo, float hi) { unsigned r; asm volatile("v_cvt_pk_bf16_f32 %0, %1, %2" : "=v"(r) : "v"(lo), "v"(hi)); return r; }
__device__ __forceinline__ float bf_lo(unsigned w) { return __builtin_bit_cast(float, w << 16); }
__device__ __forceinline__ float bf_hi(unsigned w) { return __builtin_bit_cast(float, w & 0xffff0000u); }
__device__ __forceinline__ float fsigmoid(float x) { return __builtin_amdgcn_rcpf(1.f + __expf(-x)); }
__device__ __forceinline__ float fgelu_tanh(float x) { const float u = 0.7978845608028654f * (x + 0.044715f * x * x * x); return x * fsigmoid(2.f * u); }


struct EpiSwiglu {
    static constexpr bool PERM = true, AFTER_DRAIN = false;
    bf16_t* O;
    __device__ __forceinline__ void operator()(const f32x4 (&acc)[2][2][4][2], const Unit& u, int wr, int wc, int fr, int fq) const {
        const int row0 = u.pm * BM + wr * 64 + fr, col0 = u.pn * HALF + wc * 32 + 8 * fq;
#pragma unroll
        for (int ai = 0; ai < 2; ++ai)
#pragma unroll
            for (int m = 0; m < 4; ++m) { const f32x4 g0 = acc[ai][0][m][0], g1 = acc[ai][0][m][1], u0 = acc[ai][1][m][0], u1 = acc[ai][1][m][1];
                u32x4 w;
                w.x = cvt_pk_bf16(g0[0] * fsigmoid(g0[0]) * u0[0], g0[1] * fsigmoid(g0[1]) * u0[1]); w.y = cvt_pk_bf16(g0[2] * fsigmoid(g0[2]) * u0[2], g0[3] * fsigmoid(g0[3]) * u0[3]);
                w.z = cvt_pk_bf16(g1[0] * fsigmoid(g1[0]) * u1[0], g1[1] * fsigmoid(g1[1]) * u1[1]); w.w = cvt_pk_bf16(g1[2] * fsigmoid(g1[2]) * u1[2], g1[3] * fsigmoid(g1[3]) * u1[3]);
                *(u32x4*)(O + (size_t)(row0 + ai * HALF + m * 16) * 2816 + col0) = w; }
    }
};
typedef _Float16 h16x8 __attribute__((ext_vector_type(8)));
typedef _Float16 h16x4 __attribute__((ext_vector_type(4)));
struct EpiResid {
    static constexpr bool PERM = true, AFTER_DRAIN = false;
    const float* base_lo; const float* base_hi; _Float16* z16; float alpha, s;
    const float* const* lnp; unsigned char* const* wsp; int lnidx;
    __device__ __forceinline__ void operator()(const f32x4 (&acc)[2][2][4][2], const Unit& u, int wr, int wc, int fr, int fq) const {
        const int col0 = u.pn * BM + wc * 32 + 8 * fq;
        if (lnidx >= 0) {
            const float* stats = (const float*)(*wsp + 262144); const float* lg = lnp[0] + (size_t)lnidx * 1024; const float* lb = lnp[1] + (size_t)lnidx * 1024;
            float mean[2][4], rstd[2][4];
#pragma unroll
            for (int ai = 0; ai < 2; ++ai)
#pragma unroll
                for (int m = 0; m < 4; ++m) { const f32x2 st = *(const f32x2*)(stats + 2 * (size_t)(u.pm * BM + ai * HALF + wr * 64 + m * 16 + fr)); mean[ai][m] = st.x; rstd[ai][m] = st.y * alpha; }
#pragma unroll
            for (int bj = 0; bj < 2; ++bj) { const f32x4 g0 = *(const f32x4*)(lg + col0 + bj * HALF), g1 = *(const f32x4*)(lg + col0 + bj * HALF + 4), b0 = *(const f32x4*)(lb + col0 + bj * HALF) * alpha, b1 = *(const f32x4*)(lb + col0 + bj * HALF + 4) * alpha;
#pragma unroll
                for (int ai = 0; ai < 2; ++ai)
#pragma unroll
                    for (int m = 0; m < 4; ++m) { _Float16* zp = z16 + (size_t)(u.pm * BM + ai * HALF + wr * 64 + m * 16 + fr) * 1024 + col0 + bj * HALF;
                        const h16x8 zh = *(const h16x8*)zp;
                        const f32x4 z0 = __builtin_convertvector(__builtin_shufflevector(zh, zh, 0, 1, 2, 3), f32x4), z1 = __builtin_convertvector(__builtin_shufflevector(zh, zh, 4, 5, 6, 7), f32x4);
                        const f32x4 o0 = (z0 - mean[ai][m]) * rstd[ai][m] * g0 + b0 + acc[ai][bj][m][0] * s, o1 = (z1 - mean[ai][m]) * rstd[ai][m] * g1 + b1 + acc[ai][bj][m][1] * s;
                        const h16x4 h0 = __builtin_convertvector(o0, h16x4), h1 = __builtin_convertvector(o1, h16x4);
                        *(h16x8*)zp = __builtin_shufflevector(h0, h1, 0, 1, 2, 3, 4, 5, 6, 7); }
                asm volatile("" ::: "memory"); }
        } else {
            const float* base = (u.pm < 64) ? base_lo : base_hi;
#pragma unroll
            for (int ai = 0; ai < 2; ++ai)
#pragma unroll
                for (int m = 0; m < 4; ++m) { const size_t off = (size_t)(u.pm * BM + ai * HALF + wr * 64 + m * 16 + fr) * 1024 + col0;
#pragma unroll
                    for (int bj = 0; bj < 2; ++bj) { const f32x4 x0 = *(const f32x4*)(base + off + bj * HALF), x1 = *(const f32x4*)(base + off + bj * HALF + 4);
                        const f32x4 o0 = x0 * alpha + acc[ai][bj][m][0] * s, o1 = x1 * alpha + acc[ai][bj][m][1] * s;
                        const h16x4 h0 = __builtin_convertvector(o0, h16x4), h1 = __builtin_convertvector(o1, h16x4);
                        *(h16x8*)(z16 + off + bj * HALF) = __builtin_shufflevector(h0, h1, 0, 1, 2, 3, 4, 5, 6, 7); } }
        }
    }
};
struct EpiBf16 {
    static constexpr bool PERM = true, AFTER_DRAIN = false;
    bf16_t* O; int ldc, coff;
    __device__ __forceinline__ void operator()(const f32x4 (&acc)[2][2][4][2], const Unit& u, int wr, int wc, int fr, int fq) const {
        const int row0 = u.pm * BM + wr * 64 + fr, col0 = coff + u.pn * BM + wc * 32 + 8 * fq;
#pragma unroll
        for (int ai = 0; ai < 2; ++ai)
#pragma unroll
            for (int m = 0; m < 4; ++m) { bf16_t* rowp = O + (size_t)(row0 + ai * HALF + m * 16) * ldc + col0;
#pragma unroll
                for (int bj = 0; bj < 2; ++bj) { const f32x4 v0 = acc[ai][bj][m][0], v1 = acc[ai][bj][m][1];
                    u32x4 w; w.x = cvt_pk_bf16(v0[0], v0[1]); w.y = cvt_pk_bf16(v0[2], v0[3]); w.z = cvt_pk_bf16(v1[0], v1[1]); w.w = cvt_pk_bf16(v1[2], v1[3]);
                    *(u32x4*)(rowp + bj * HALF) = w; } }
    }
};
struct EpiWin {
    static constexpr bool PERM = true, AFTER_DRAIN = false;
    bf16_t* QKVX; bf16_t* GR; bf16_t* QM;
    __device__ __forceinline__ void operator()(const f32x4 (&acc)[2][2][4][2], const Unit& u, int wr, int wc, int fr, int fq) const {
        const int row0 = u.pm * BM + wr * 64 + fr; const int pn = u.pn;
        bf16_t* base; int ldc, colt; float sc = 1.f; bool gel = false;
        if (pn < 12) { base = QKVX; ldc = 3072; colt = pn * BM; if (pn < 3) sc = 0.125f; }
        else if (pn < 15) { base = GR; ldc = 768; colt = (pn - 12) * BM; gel = true; }
        else { base = QM; ldc = 512; colt = (pn - 15) * BM; sc = 0.08838834764831845f; }
        const int col0 = colt + wc * 32 + 8 * fq;
#pragma unroll
        for (int ai = 0; ai < 2; ++ai)
#pragma unroll
            for (int m = 0; m < 4; ++m) { bf16_t* rowp = base + (size_t)(row0 + ai * HALF + m * 16) * ldc + col0;
#pragma unroll
                for (int bj = 0; bj < 2; ++bj) { f32x4 v0 = acc[ai][bj][m][0], v1 = acc[ai][bj][m][1];
                    if (gel) {
#pragma unroll
                        for (int e = 0; e < 4; ++e) { v0[e] = fgelu_tanh(v0[e]); v1[e] = fgelu_tanh(v1[e]); } }
                    v0 = v0 * sc; v1 = v1 * sc;
                    u32x4 w; w.x = cvt_pk_bf16(v0[0], v0[1]); w.y = cvt_pk_bf16(v0[2], v0[3]); w.z = cvt_pk_bf16(v1[0], v1[1]); w.w = cvt_pk_bf16(v1[2], v1[3]);
                    *(u32x4*)(rowp + bj * HALF) = w; } }
    }
};
struct EpiGate {
    static constexpr bool PERM = true, AFTER_DRAIN = false;
    bf16_t* G; const float* bg;
    __device__ __forceinline__ void operator()(const f32x4 (&acc)[2][2][4][2], const Unit& u, int wr, int wc, int fr, int fq) const {
        const int br = u.pn >> 2, row0 = u.pm * BM + wr * 64 + fr, col0 = (u.pn & 3) * BM + wc * 32 + 8 * fq;
#pragma unroll
        for (int bj = 0; bj < 2; ++bj) { const f32x4 b0 = *(const f32x4*)(bg + br * 1024 + col0 + bj * HALF), b1 = *(const f32x4*)(bg + br * 1024 + col0 + bj * HALF + 4);
#pragma unroll
            for (int ai = 0; ai < 2; ++ai)
#pragma unroll
                for (int m = 0; m < 4; ++m) { bf16_t* pm_ = G + (size_t)(row0 + ai * HALF + m * 16) * 3072 + col0 + bj * HALF;
                    const u32x4 pv = *(const u32x4*)(pm_ + br * 1024); u32x4 mv = (u32x4){0u, 0u, 0u, 0u}; if (br) mv = *(const u32x4*)pm_;
                    const f32x4 v0 = acc[ai][bj][m][0] + b0, v1 = acc[ai][bj][m][1] + b1;
                    u32x4 w;
                    w.x = cvt_pk_bf16(bf_lo(mv.x) + fsigmoid(v0[0]) * bf_lo(pv.x), bf_hi(mv.x) + fsigmoid(v0[1]) * bf_hi(pv.x));
                    w.y = cvt_pk_bf16(bf_lo(mv.y) + fsigmoid(v0[2]) * bf_lo(pv.y), bf_hi(mv.y) + fsigmoid(v0[3]) * bf_hi(pv.y));
                    w.z = cvt_pk_bf16(bf_lo(mv.z) + fsigmoid(v1[0]) * bf_lo(pv.z), bf_hi(mv.z) + fsigmoid(v1[1]) * bf_hi(pv.z));
                    w.w = cvt_pk_bf16(bf_lo(mv.w) + fsigmoid(v1[2]) * bf_lo(pv.w), bf_hi(mv.w) + fsigmoid(v1[3]) * bf_hi(pv.w));
                    *(u32x4*)pm_ = w; } }
    }
};

template <class Epi, class Sched, bool ALIGN_EPI = false, bool SP2 = false>
__device__ __forceinline__ void gemm_phase(PG8_LAS unsigned char* lds, const Gemm g, const Sched& S, const Epi& E) {
    int tid_ = threadIdx.x; asm volatile("" : "+v"(tid_));
    const int tid = tid_, wid = __builtin_amdgcn_readfirstlane(tid >> 6), lane = tid & 63, wr = wid >> 2, wc = wid & 3, fr = lane & 15, fq = lane >> 4;
    const int K = g.K, nt = K / BK;
    unsigned voffA[2], voffB[2];
#pragma unroll
    for (int i = 0; i < 2; ++i) { int R, C; stage_rc(tid * 16 + i * 8192, R, C); const int Rb = Epi::PERM ? ((R & ~31) + perm32(R & 31)) : R;
        voffA[i] = (unsigned)(R * g.lda + C) * 2u; voffB[i] = (unsigned)(Rb * K + C) * 2u; }
    const size_t kstep = (size_t)(BK * 2);
    const size_t hstep = (size_t)HALF * K * 2, hstepA = (size_t)HALF * g.lda * 2;
    const size_t tstep = 2 * hstep, tstepA = 2 * hstepA;
    const unsigned ldsw = (unsigned)wid * 1024u;
    const int aoff = lds_byte(wr * 64 + fr, fq * 8), boff = lds_byte(wc * 32 + fr, fq * 8);
#define PG8_SA(b, h) (((b) * 2 + (h)) * HTB)
#define PG8_SB(b, h) ((4 + (b) * 2 + (h)) * HTB)
#define PG8_STAGE(bufoff, gbase, voff) do { _Pragma("unroll") for (int _i = 0; _i < 2; ++_i) \
        __builtin_amdgcn_global_load_lds((const unsigned*)((const char*)(gbase) + (voff)[_i]), (PG8_LAS unsigned*)(lds + (bufoff) + ldsw + _i * 8192), 16, 0, 0); } while (0)
#define PG8_LDA(dst, b, h) do { _Pragma("unroll") for (int m = 0; m < 4; ++m) _Pragma("unroll") for (int k = 0; k < 2; ++k) dst[m][k] = *(const PG8_LAS bf16x8*)(lds + PG8_SA(b, h) + aoff + m * 2048 + k * 1024); } while (0)
#define PG8_LDB(dst, b, h) do { _Pragma("unroll") for (int n = 0; n < 2; ++n) _Pragma("unroll") for (int k = 0; k < 2; ++k) dst[n][k] = *(const PG8_LAS bf16x8*)(lds + PG8_SB(b, h) + boff + n * 2048 + k * 1024); } while (0)
#define PG8_MMA(ai, bj, At, Bt) do { __builtin_amdgcn_s_setprio(1); _Pragma("unroll") for (int m = 0; m < 4; ++m) _Pragma("unroll") for (int n = 0; n < 2; ++n) _Pragma("unroll") for (int k = 0; k < 2; ++k) \
        acc[ai][bj][m][n] = __builtin_amdgcn_mfma_f32_16x16x32_bf16(Bt[n][k], At[m][k], acc[ai][bj][m][n], 0, 0, 0); __builtin_amdgcn_s_setprio(0); } while (0)
#define PG8_WAIT_V(n) asm volatile("s_waitcnt vmcnt(" #n ")" ::: "memory")
#define PG8_WAIT_L(n) asm volatile("s_waitcnt lgkmcnt(" #n ")" ::: "memory")
#define PG8_BAR __builtin_amdgcn_s_barrier()
#define PG8_SCHED __builtin_amdgcn_sched_barrier(0)
    Unit cur, nxt; int ui = 0;
    if (!S.next(0, cur)) return;
    f32x4 acc[2][2][4][2];
#pragma unroll
    for (int a = 0; a < 2; ++a)
#pragma unroll
        for (int b = 0; b < 2; ++b)
#pragma unroll
            for (int m = 0; m < 4; ++m)
#pragma unroll
                for (int n = 0; n < 2; ++n) acc[a][b][m][n] = (f32x4){0.f, 0.f, 0.f, 0.f};
    bf16x8 At[4][2], B0[2][2], B1[2][2];
    const char* cA = (const char*)g.A + (size_t)cur.pm * tstepA; const char* cB = (const char*)g.Bt + (size_t)cur.pn * tstep;
    S.a_ready(cur);
    if constexpr (SP2) {
        PG8_STAGE(PG8_SB(0, 0), cB, voffB); PG8_STAGE(PG8_SB(0, 1), cB + hstep, voffB); PG8_STAGE(PG8_SA(0, 0), cA, voffA); PG8_STAGE(PG8_SA(0, 1), cA + hstepA, voffA);
        if (wr == 1) PG8_BAR;
        PG8_WAIT_V(2); PG8_BAR;
        PG8_STAGE(PG8_SB(1, 0), cB + kstep, voffB); PG8_STAGE(PG8_SA(1, 0), cA + kstep, voffA); PG8_STAGE(PG8_SB(1, 1), cB + hstep + kstep, voffB);
        PG8_WAIT_V(6); PG8_BAR;
    } else {
        PG8_STAGE(PG8_SB(0, 0), cB, voffB); PG8_STAGE(PG8_SA(0, 0), cA, voffA); PG8_STAGE(PG8_SB(0, 1), cB + hstep, voffB); PG8_STAGE(PG8_SA(0, 1), cA + hstepA, voffA);
        if (wr == 1) PG8_BAR;
        PG8_WAIT_V(4); PG8_BAR;
        PG8_STAGE(PG8_SB(1, 0), cB + kstep, voffB); PG8_STAGE(PG8_SA(1, 0), cA + kstep, voffA); PG8_STAGE(PG8_SB(1, 1), cB + hstep + kstep, voffB);
        PG8_WAIT_V(6); PG8_BAR;
    }
    for (;;) {
        const bool has_next = S.next(ui + 1, nxt);
        const char* nA = has_next ? (const char*)g.A + (size_t)nxt.pm * tstepA : cA; const char* nB = has_next ? (const char*)g.Bt + (size_t)nxt.pn * tstep : cB;
        for (int t = 0; t < nt; t += 2) {
            const bool last = (t == nt - 2);
            const char* a1 = cA + (size_t)(t + 1) * kstep;
            const char* a2 = last ? nA : cA + (size_t)(t + 2) * kstep; const char* b2 = last ? nB : cB + (size_t)(t + 2) * kstep;
            const char* a3 = a2 + kstep; const char* b3 = b2 + kstep;
            if (last && has_next) S.a_ready(nxt);
            if constexpr (SP2) {
            PG8_LDB(B0, 0, 0); PG8_LDB(B1, 0, 1); PG8_SCHED; PG8_LDA(At, 0, 0); PG8_STAGE(PG8_SA(1, 1), a1 + hstepA, voffA);
            PG8_WAIT_V(8); PG8_WAIT_L(0); PG8_BAR; PG8_MMA(0, 0, At, B0); PG8_MMA(0, 1, At, B1); PG8_BAR; PG8_SCHED;
            PG8_LDA(At, 0, 1); PG8_STAGE(PG8_SB(0, 0), b2, voffB); PG8_STAGE(PG8_SB(0, 1), b2 + hstep, voffB); PG8_STAGE(PG8_SA(0, 0), a2, voffA);
            PG8_WAIT_V(8); PG8_WAIT_L(0); PG8_BAR; PG8_MMA(1, 0, At, B0); PG8_MMA(1, 1, At, B1); PG8_BAR; PG8_SCHED;
            PG8_LDB(B0, 1, 0); PG8_LDB(B1, 1, 1); PG8_SCHED; PG8_LDA(At, 1, 0); PG8_STAGE(PG8_SA(0, 1), a2 + hstepA, voffA);
            PG8_WAIT_V(8); PG8_WAIT_L(0); PG8_BAR; PG8_MMA(0, 0, At, B0); PG8_MMA(0, 1, At, B1); PG8_BAR; PG8_SCHED;
            PG8_LDA(At, 1, 1); PG8_STAGE(PG8_SB(1, 0), b3, voffB); PG8_STAGE(PG8_SB(1, 1), b3 + hstep, voffB); PG8_STAGE(PG8_SA(1, 0), a3, voffA);
            PG8_WAIT_V(8); PG8_WAIT_L(0); PG8_BAR; PG8_MMA(1, 0, At, B0); PG8_MMA(1, 1, At, B1); PG8_BAR; PG8_SCHED;
            } else {
            PG8_LDB(B0, 0, 0); PG8_SCHED; PG8_LDA(At, 0, 0); PG8_STAGE(PG8_SA(1, 1), a1 + hstepA, voffA);
            PG8_WAIT_L(8); PG8_BAR; PG8_WAIT_L(0); PG8_MMA(0, 0, At, B0); PG8_BAR; PG8_SCHED;
            PG8_LDB(B1, 0, 1); PG8_STAGE(PG8_SB(0, 0), b2, voffB);
            PG8_BAR; PG8_WAIT_L(0); PG8_MMA(0, 1, At, B1); PG8_BAR;
            PG8_LDA(At, 0, 1); PG8_STAGE(PG8_SA(0, 0), a2, voffA);
            PG8_BAR; PG8_WAIT_L(0); PG8_MMA(1, 0, At, B0); PG8_BAR; PG8_SCHED;
            PG8_STAGE(PG8_SB(0, 1), b2 + hstep, voffB);
            PG8_WAIT_V(6); PG8_BAR; PG8_MMA(1, 1, At, B1); PG8_BAR;
            PG8_LDB(B0, 1, 0); PG8_SCHED; PG8_LDA(At, 1, 0); PG8_STAGE(PG8_SA(0, 1), a2 + hstepA, voffA);
            PG8_WAIT_L(8); PG8_BAR; PG8_WAIT_L(0); PG8_MMA(0, 0, At, B0); PG8_BAR; PG8_SCHED;
            PG8_LDB(B1, 1, 1); PG8_STAGE(PG8_SB(1, 0), b3, voffB);
            PG8_BAR; PG8_WAIT_L(0); PG8_MMA(0, 1, At, B1); PG8_BAR;
            PG8_LDA(At, 1, 1); PG8_STAGE(PG8_SA(1, 0), a3, voffA);
            PG8_BAR; PG8_WAIT_L(0); PG8_MMA(1, 0, At, B0); PG8_BAR; PG8_SCHED;
            PG8_STAGE(PG8_SB(1, 1), b3 + hstep, voffB);
            PG8_WAIT_V(6); PG8_BAR; PG8_MMA(1, 1, At, B1); PG8_BAR;
            }
        }
        if constexpr (ALIGN_EPI) { if (wr == 0) PG8_BAR; }
        if constexpr (!Epi::AFTER_DRAIN) { E(acc, cur, wr, wc, fr, fq); S.done(cur); }
        if (!has_next) break;
#pragma unroll
        for (int a = 0; a < 2; ++a)
#pragma unroll
            for (int b = 0; b < 2; ++b)
#pragma unroll
                for (int m = 0; m < 4; ++m)
#pragma unroll
                    for (int n = 0; n < 2; ++n) acc[a][b][m][n] = (f32x4){0.f, 0.f, 0.f, 0.f};
        cur = nxt; cA = nA; cB = nB; ++ui;
        if constexpr (ALIGN_EPI) { if (wr == 1) PG8_BAR; }
    }
    PG8_WAIT_V(0);
    if constexpr (!ALIGN_EPI) { if (wr == 0) PG8_BAR; }
    PG8_BAR;
#undef PG8_SA
#undef PG8_SB
#undef PG8_STAGE
#undef PG8_LDA
#undef PG8_LDB
#undef PG8_MMA
#undef PG8_WAIT_V
#undef PG8_WAIT_L
#undef PG8_BAR
#undef PG8_SCHED
}
}

#define LAS __attribute__((address_space(3)))
typedef unsigned short bf16;
typedef unsigned v4u __attribute__((ext_vector_type(4)));
typedef float f32x4 __attribute__((ext_vector_type(4)));
typedef float f32x2 __attribute__((ext_vector_type(2)));
typedef short bf16x8 __attribute__((ext_vector_type(8)));
constexpr int T = 32768, D = 1024, DFF = 2816, NCHUNK = T / 64, DIN = 7424;
constexpr int NWAVES = 8, NTHR = 512;
constexpr float ALPHA = 1.4142135623730951f, LN_EPS = 1e-5f;
constexpr int LDS_BYTES = 147456;
constexpr size_t MiB = 1u << 20;
constexpr size_t WS_WT = 1 * MiB, WS_XB = 61 * MiB, WS_MEMB = 125 * MiB, WS_MEMKV = 130 * MiB, WS_CAR = 135 * MiB, WS_CIN = 141 * MiB, WS_LSE = 144 * MiB,
                 WS_QKVX = 146 * MiB, WS_ACT = 146 * MiB, WS_GR = 338 * MiB, WS_QM = 386 * MiB, WS_ATTN = 418 * MiB, WS_Z16 = 434 * MiB, WS_END = 498 * MiB;
constexpr size_t WT_FFIN0 = 0, WT_FFIN1 = 5767168, WT_FFOUT0 = 11534336, WT_FFOUT1 = 14417920, WT_WIN = 17301504, WT_MEMKV = 24903680,
                 WT_BRA = 25952256, WT_BRL = 26214400, WT_BRM = 27000832, WT_WOUT = 27525120, WT_LRU = 30670848, WT_END = 30867456;
static_assert(WT_END * 2 <= 60 * MiB, "weights fit");

struct Params {
    const float* x_prompt; const float* x_sample; const float* mem_prompt; const float* mem_sample; const float* rel_bias;
    const float* w_in; const float* b_gate; const float* conv_w; const float* conv_b; const float* lru_wa; const float* lru_ba;
    const float* lru_wx; const float* lru_bx; const float* lru_lambda; const float* w_mem_kv; const float* w_br_attn; const float* w_br_lru;
    const float* w_br_mem; const float* w_out; const float* ff_in; const float* ff_out; const float* ln_g; const float* ln_b;
    float* out; unsigned char* ws; int ph_lo, ph_hi;
};

__device__ __forceinline__ unsigned f2bf(float f) { unsigned u = __builtin_bit_cast(unsigned, f); return (u + 0x7fffu + ((u >> 16) & 1u)) >> 16; }
__device__ __forceinline__ unsigned pk2(float lo, float hi) { return f2bf(lo) | (f2bf(hi) << 16); }
__device__ __forceinline__ float bflo(unsigned w) { return __builtin_bit_cast(float, w << 16); }
__device__ __forceinline__ float bfhi(unsigned w) { return __builtin_bit_cast(float, w & 0xffff0000u); }
__device__ __forceinline__ float wave_sum(float v) {
#pragma unroll
    for (int o = 1; o < 64; o <<= 1) v += __shfl_xor(v, o);
    return v;
}
#define LDS_WAIT() asm volatile("s_waitcnt lgkmcnt(0)" ::: "memory")

__device__ __forceinline__ void cvt_item(const float* W, int ldw, bf16* WT, int pitch, int drow0, int k0, int n0, LAS float* scr, int lane) {
    float wv[32];
#pragma unroll
    for (int i = 0; i < 32; ++i) wv[i] = W[(size_t)(k0 + 2 * i + (lane >> 5)) * ldw + n0 + (lane & 31)];
#pragma unroll
    for (int i = 0; i < 32; ++i) scr[(2 * i + (lane >> 5)) * 33 + (lane & 31)] = wv[i];
    LDS_WAIT(); asm volatile("" ::: "memory");
    const int c = lane & 7;
#pragma unroll
    for (int j = 0; j < 4; ++j) { const int n = (lane >> 3) + 8 * j; const LAS float* s = scr + (8 * c) * 33 + n;
        v4u o; o.x = pk2(s[0 * 33], s[1 * 33]); o.y = pk2(s[2 * 33], s[3 * 33]); o.z = pk2(s[4 * 33], s[5 * 33]); o.w = pk2(s[6 * 33], s[7 * 33]);
        *(v4u*)(WT + (size_t)(drow0 + n) * pitch + k0 + 8 * c) = o; }
    LDS_WAIT(); asm volatile("" ::: "memory");
}
constexpr int CVT_ITEMS = 14048;
__device__ __forceinline__ void cvt_weights(const Params& p, int L, LAS unsigned char* lds, int gw, int ngw, int wave, int lane) {
    LAS float* scr = (LAS float*)(lds + wave * 16384);
    bf16* WT = (bf16*)(p.ws + WS_WT);
    for (int i = gw * 64 + lane; i < 1536; i += ngw * 64) { const float lm = p.lru_lambda[(size_t)L * 1536 + i]; ((float*)(p.ws + 65536))[i] = 8.f * ((lm > 15.f) ? __expf(-lm) : log1pf(__expf(-lm))); }
    for (int it = gw; it < CVT_ITEMS; it += ngw) {
        int r = it; const float* src; int ldw, K, Nc, pitch, gu = -1; bf16* dst;
        if (r < 5632) { const int j = r / 1408; r -= j * 1408; const int f = j >> 1, up = j & 1;
            src = p.ff_in + (size_t)(L * 2 + f) * 1024 * 5632 + up * 2816; ldw = 5632; K = 1024; Nc = 2816; dst = WT + (f ? WT_FFIN1 : WT_FFIN0); pitch = 1024; gu = up; }
        else if ((r -= 5632) < 2816) { const int f = r / 1408; r -= f * 1408;
            src = p.ff_out + (size_t)(L * 2 + f) * 2816 * 1024; ldw = 1024; K = 2816; Nc = 1024; dst = WT + (f ? WT_FFOUT1 : WT_FFOUT0); pitch = 2816; }
        else if ((r -= 2816) < 3712) { src = p.w_in + (size_t)L * 1024 * DIN; ldw = DIN; K = 1024; Nc = DIN; dst = WT + WT_WIN; pitch = 1024; }
        else if ((r -= 3712) < 512) { src = p.w_mem_kv + (size_t)L * 1024 * 1024; ldw = 1024; K = 1024; Nc = 1024; dst = WT + WT_MEMKV; pitch = 1024; }
        else if ((r -= 512) < 128) { src = p.w_br_attn + (size_t)L * 256 * 1024; ldw = 1024; K = 256; Nc = 1024; dst = WT + WT_BRA; pitch = 256; }
        else if ((r -= 128) < 384) { src = p.w_br_lru + (size_t)L * 768 * 1024; ldw = 1024; K = 768; Nc = 1024; dst = WT + WT_BRL; pitch = 768; }
        else if ((r -= 384) < 256) { src = p.w_br_mem + (size_t)L * 512 * 1024; ldw = 1024; K = 512; Nc = 1024; dst = WT + WT_BRM; pitch = 512; }
        else if ((r -= 256) < 512) { src = p.w_out + (size_t)L * 1024 * 1024; ldw = 1024; K = 1024; Nc = 1024; dst = WT + WT_WOUT; pitch = 1024; }
        else { r -= 512; const int mi = r >> 1; r &= 1; const int g = mi / 24, dir = (mi % 24) / 12, blk = mi % 12;
            src = (g ? p.lru_wx : p.lru_wa) + (size_t)((L * 2 + dir) * 12 + blk) * 4096; ldw = 64; K = 64; Nc = 64; dst = WT + WT_LRU + (size_t)(((dir * 12 + blk) * 2 + g) * 64) * 64; pitch = 64; }
        const int nblk = Nc / 32, kb = r / nblk, nb = r % nblk;
        const int n0 = 32 * nb, drow0 = gu < 0 ? n0 : (n0 >> 7) * 256 + (n0 & 127) + gu * 128;
        cvt_item(src, ldw, dst, pitch, drow0, 64 * kb, n0, scr, lane);
    }
}
__device__ __forceinline__ void cvt_row(const float* xrow, bf16* orow, int lane) {
    const f32x4* xr = (const f32x4*)xrow + lane; unsigned long long* o8 = (unsigned long long*)orow + lane;
#pragma unroll
    for (int j = 0; j < 4; ++j) { const f32x4 v = xr[64 * j]; o8[64 * j] = (unsigned long long)pk2(v.x, v.y) | ((unsigned long long)pk2(v.z, v.w) << 32); }
}
template <int NR>
__device__ __forceinline__ void ln_rows(const _Float16* z, bf16* xb, float* st, float* outf, int m0, int stride, const float* g, const float* b, int lane, bool final_out) {
    typedef _Float16 h16x4 __attribute__((ext_vector_type(4)));
    f32x4 v[NR][4]; float s[NR];
#pragma unroll
    for (int r = 0; r < NR; ++r) { const h16x4* zr = (const h16x4*)(z + (size_t)(m0 + r * stride) * D) + lane; s[r] = 0.f;
#pragma unroll
        for (int j = 0; j < 4; ++j) v[r][j] = __builtin_convertvector(zr[64 * j], f32x4); }
#pragma unroll
    for (int r = 0; r < NR; ++r)
#pragma unroll
        for (int j = 0; j < 4; ++j) s[r] += (v[r][j].x + v[r][j].y) + (v[r][j].z + v[r][j].w);
#pragma unroll
    for (int o = 1; o < 64; o <<= 1)
#pragma unroll
        for (int r = 0; r < NR; ++r) s[r] += __shfl_xor(s[r], o);
    float mean[NR], s2[NR];
#pragma unroll
    for (int r = 0; r < NR; ++r) { mean[r] = s[r] * (1.f / D); s2[r] = 0.f;
#pragma unroll
        for (int j = 0; j < 4; ++j) { v[r][j] = v[r][j] - mean[r]; s2[r] += (v[r][j].x * v[r][j].x + v[r][j].y * v[r][j].y) + (v[r][j].z * v[r][j].z + v[r][j].w * v[r][j].w); } }
#pragma unroll
    for (int o = 1; o < 64; o <<= 1)
#pragma unroll
        for (int r = 0; r < NR; ++r) s2[r] += __shfl_xor(s2[r], o);
#pragma unroll
    for (int r = 0; r < NR; ++r) { const int m = m0 + r * stride; const float rstd = 1.f / sqrtf(s2[r] * (1.f / D) + LN_EPS);
        if (!final_out && lane == 0) *(f32x2*)(st + 2 * (size_t)m) = (f32x2){mean[r], rstd};
        f32x4* xr = (f32x4*)(outf + (size_t)m * D) + lane; unsigned long long* o8 = (unsigned long long*)(xb + (size_t)m * D) + lane;
#pragma unroll
        for (int j = 0; j < 4; ++j) { const f32x4 gg = ((const f32x4*)g)[lane + 64 * j], bb = ((const f32x4*)b)[lane + 64 * j];
            const f32x4 y = v[r][j] * rstd * gg + bb;
            if (final_out) xr[64 * j] = y;
            else o8[64 * j] = (unsigned long long)pk2(y.x, y.y) | ((unsigned long long)pk2(y.z, y.w) << 32); } }
}

__device__ __forceinline__ int t5_bucket(int rel) {
    const int n = rel < 0 ? -rel : rel;
    int b = n < 8 ? n : 8 + (n >= 15) + (n >= 27) + (n >= 50) + (n >= 91) + (n >= 166) + (n >= 305) + (n >= 559);
    return b + (rel > 0 ? 16 : 0);
}

#define MFMA16(a, b, c) __builtin_amdgcn_mfma_f32_16x16x32_bf16(a, b, c, 0, 0, 0)
typedef short v4i16_t __attribute__((ext_vector_type(4)));
__device__ __forceinline__ v4i16_t vtr(const LAS unsigned char* p) { return __builtin_amdgcn_ds_read_tr16_b64_v4i16((LAS v4i16_t*)p); }

constexpr int AT_KS = 0, AT_VT = 27648, AT_BIAS = 27648 + 30720, AT_HALF = 58944;
struct AttnIdx { int hh, m0, dsh, n, r, nb; };
__device__ __forceinline__ AttnIdx attn_index(int P, int hw) {
    AttnIdx X; X.hh = 2 * (P >> 9) + hw; const int tq = P & 511; int S, lt;
    if (tq < 256) { X.m0 = (tq >> 7) * 8192; lt = tq & 127; S = 8192; } else { const int t = tq - 256; X.m0 = 16384 + (t >> 5) * 2048; lt = t & 31; S = 2048; }
    X.dsh = 2 * (X.hh >> 2); X.n = S >> X.dsh; const int nblk = X.n >> 6; X.r = lt / nblk; X.nb = lt % nblk; return X;
}
__device__ __forceinline__ void attn_load(const Params& p, const AttnIdx& X, int t2, int wq, int fr, int fq, v4u (&kv)[6], v4u (&vv)[6], bf16x8 (&qa)[2], float& bv) {
    const bf16* QKVX = (const bf16*)(p.ws + WS_QKVX); const int d = 1 << X.dsh;
#pragma unroll
    for (int k = 0; k < 6; ++k) { const int c = k * 256 + t2;
        { const int key = c >> 3, d8 = c & 7, jk = X.nb * 64 - 64 + key; kv[k] = (v4u){0u, 0u, 0u, 0u};
          if (jk >= 0 && jk < X.n) kv[k] = *(const v4u*)(QKVX + (size_t)(X.m0 + jk * d + X.r) * 3072 + 768 + X.hh * 64 + d8 * 8); }
        { const int key = c >> 3, d8 = c & 7, jk = X.nb * 64 - 64 + key; vv[k] = (v4u){0u, 0u, 0u, 0u};
          if (jk >= 0 && jk < X.n) vv[k] = *(const v4u*)(QKVX + (size_t)(X.m0 + jk * d + X.r) * 3072 + 1536 + X.hh * 64 + d8 * 8); } }
    bv = 0.f; if (t2 < 129) bv = p.rel_bias[t5_bucket((t2 - 64) * d) * 12 + X.hh];
    const bf16* qp = QKVX + (size_t)(X.m0 + (X.nb * 64 + 16 * wq + fr) * d + X.r) * 3072 + X.hh * 64 + 8 * fq;
    qa[0] = *(const bf16x8*)qp; qa[1] = *(const bf16x8*)(qp + 32);
}
__device__ __forceinline__ void attn_phase(const Params& p, LAS unsigned char* lds, const int bx, const int G, const int tid) {
    const int hw = tid >> 8, t2 = tid & 255, lane = tid & 63, wq = (tid >> 6) & 3, fr = lane & 15, fq = lane >> 4;
    LAS unsigned char* L = lds + hw * AT_HALF;
    bf16* QKVX = (bf16*)(p.ws + WS_QKVX); float* LSE = (float*)(p.ws + WS_LSE);
    v4u kv[6], vv[6]; bf16x8 qn[2]; float bv;
    int it = (G == 256) ? (bx & 7) * 32 + (bx >> 3) : bx;
    if (it < 3072) { const AttnIdx X0 = attn_index(it, hw); attn_load(p, X0, t2, wq, fr, fq, kv, vv, qn, bv); }
    for (; it < 3072; it += G) {
        const AttnIdx X = attn_index(it, hw); const int d = 1 << X.dsh;
#pragma unroll
        for (int k = 0; k < 6; ++k) { const int c = k * 256 + t2;
            *(LAS v4u*)(L + AT_KS + (c >> 3) * 144 + (c & 7) * 16) = kv[k];
            *(LAS v4u*)(L + AT_VT + (c >> 3) * 160 + (c & 7) * 16) = vv[k]; }
        if (t2 < 129) ((LAS float*)(L + AT_BIAS))[t2] = bv;
        const bf16x8 q0 = qn[0], q1 = qn[1];
        __syncthreads();
        if (it + G < 3072) { const AttnIdx X1 = attn_index(it + G, hw); attn_load(p, X1, t2, wq, fr, fq, kv, vv, qn, bv); }
        f32x4 st[12];
#pragma unroll
        for (int ct = 0; ct < 12; ++ct) { st[ct] = (f32x4){0.f, 0.f, 0.f, 0.f};
            const bf16x8 k0 = *(const LAS bf16x8*)(L + AT_KS + (16 * ct + fr) * 144 + (8 * fq) * 2), k1 = *(const LAS bf16x8*)(L + AT_KS + (16 * ct + fr) * 144 + (32 + 8 * fq) * 2);
            st[ct] = MFMA16(k0, q0, st[ct]); st[ct] = MFMA16(k1, q1, st[ct]); }
        const int qi = 16 * wq + fr; float mx = -3e38f;
#pragma unroll
        for (int ct = 0; ct < 12; ++ct)
#pragma unroll
            for (int e = 0; e < 4; ++e) { const int u = 16 * ct + 4 * fq + e, jk = X.nb * 64 - 64 + u, dl = u - 64 - qi; const bool ok = jk >= 0 && jk < X.n && dl >= -64 && dl <= 64;
                const float b = ((const LAS float*)(L + AT_BIAS))[ok ? dl + 64 : 0]; const float sv = ok ? st[ct][e] + b : -1e30f; st[ct][e] = sv; mx = fmaxf(mx, sv); }
        mx = fmaxf(mx, __shfl_xor(mx, 16)); mx = fmaxf(mx, __shfl_xor(mx, 32));
        float sm = 0.f;
#pragma unroll
        for (int ct = 0; ct < 12; ++ct)
#pragma unroll
            for (int e = 0; e < 4; ++e) { const float pv = __expf(st[ct][e] - mx); st[ct][e] = pv; sm += pv; }
        sm += __shfl_xor(sm, 16); sm += __shfl_xor(sm, 32);
        f32x4 ot[4];
#pragma unroll
        for (int dt = 0; dt < 4; ++dt) ot[dt] = (f32x4){0.f, 0.f, 0.f, 0.f};
#pragma unroll
        for (int ks = 0; ks < 6; ++ks) { v4u pw; pw.x = pk2(st[2 * ks][0], st[2 * ks][1]); pw.y = pk2(st[2 * ks][2], st[2 * ks][3]); pw.z = pk2(st[2 * ks + 1][0], st[2 * ks + 1][1]); pw.w = pk2(st[2 * ks + 1][2], st[2 * ks + 1][3]);
            const bf16x8 pb = __builtin_bit_cast(bf16x8, pw);
#pragma unroll
            for (int dt = 0; dt < 4; ++dt) { const LAS unsigned char* vr = L + AT_VT + (32 * ks + 4 * fq + (fr >> 2)) * 160 + (16 * dt + 4 * (fr & 3)) * 2;
                const v4i16_t lo = vtr(vr), hi = vtr(vr + 16 * 160);
                ot[dt] = MFMA16(__builtin_shufflevector(lo, hi, 0, 1, 2, 3, 4, 5, 6, 7), pb, ot[dt]); } }
        { const size_t m = (size_t)(X.m0 + (X.nb * 64 + qi) * d + X.r); const float inv = 1.f / sm;
#pragma unroll
          for (int dt = 0; dt < 4; ++dt) { unsigned long long w = (unsigned long long)pk2(ot[dt][0] * inv, ot[dt][1] * inv) | ((unsigned long long)pk2(ot[dt][2] * inv, ot[dt][3] * inv) << 32);
              *(unsigned long long*)(QKVX + m * 3072 + X.hh * 64 + 16 * dt + 4 * fq) = w; }
          if (fq == 0) LSE[m * 12 + X.hh] = mx + __logf(sm); }
        __syncthreads();
    }
}

constexpr int MA_KS = 0, MA_VT = 69632;
static_assert(MA_VT + 256 * 288 <= LDS_BYTES - 64, "memattn LDS map");
__device__ __forceinline__ void memattn_group(const Params& p, LAS unsigned char* lds, int grp, const int tid) {
    const int lane = tid & 63, w = tid >> 6, fr = lane & 15, fq = lane >> 4;
    bf16* QM = (bf16*)(p.ws + WS_QM); const bf16* MKV = (const bf16*)(p.ws + WS_MEMKV);
    int bi, h, mg;
    if (grp < 128) { bi = grp >> 6; h = (grp >> 4) & 3; mg = bi * 8192 + (grp & 15) * 512; }
    else { const int g2 = grp - 128; bi = 2 + (g2 >> 4); h = (g2 >> 2) & 3; mg = 16384 + (g2 >> 4) * 2048 + (g2 & 3) * 512; }
    const bf16* kbase = MKV + (size_t)(bi * 256) * 1024 + h * 128; const bf16* vbase = kbase + 512;
    { v4u kr[8], vr8[8];
#pragma unroll
      for (int k = 0; k < 8; ++k) { const int c = k * 512 + tid; kr[k] = *(const v4u*)(kbase + (size_t)(c >> 4) * 1024 + (c & 15) * 8); vr8[k] = *(const v4u*)(vbase + (size_t)(c >> 4) * 1024 + (c & 15) * 8); }
#pragma unroll
      for (int k = 0; k < 8; ++k) { const int c = k * 512 + tid; *(LAS v4u*)(lds + MA_KS + (c >> 4) * 272 + (c & 15) * 16) = kr[k];
          *(LAS v4u*)(lds + MA_VT + (c >> 4) * 288 + (c & 15) * 16) = vr8[k]; } }
    bf16x8 qn[4];
    { const bf16* qp = QM + (size_t)(mg + 16 * w + fr) * 512 + h * 128 + 8 * fq;
#pragma unroll
      for (int ks = 0; ks < 4; ++ks) qn[ks] = *(const bf16x8*)(qp + 32 * ks); }
    __syncthreads();
#pragma nounroll
    for (int j = 0; j < 4; ++j) {
        asm volatile("" ::: "memory");
        const int m0 = mg + j * 128;
        bf16x8 qa[4];
#pragma unroll
        for (int ks = 0; ks < 4; ++ks) qa[ks] = qn[ks];
        if (j < 3) { const bf16* qp = QM + (size_t)(m0 + 128 + 16 * w + fr) * 512 + h * 128 + 8 * fq;
#pragma unroll
            for (int ks = 0; ks < 4; ++ks) qn[ks] = *(const bf16x8*)(qp + 32 * ks); }
        f32x4 st[16]; float mx = -3e38f;
#pragma unroll
        for (int ct = 0; ct < 16; ++ct) { st[ct] = (f32x4){0.f, 0.f, 0.f, 0.f};
#pragma unroll
            for (int ks = 0; ks < 4; ++ks) { const bf16x8 kb = *(const LAS bf16x8*)(lds + MA_KS + (16 * ct + fr) * 272 + (32 * ks + 8 * fq) * 2); st[ct] = MFMA16(kb, qa[ks], st[ct]); }
            mx = fmaxf(fmaxf(mx, fmaxf(st[ct][0], st[ct][1])), fmaxf(st[ct][2], st[ct][3])); }
        mx = fmaxf(mx, __shfl_xor(mx, 16)); mx = fmaxf(mx, __shfl_xor(mx, 32));
        float sm = 0.f;
#pragma unroll
        for (int ct = 0; ct < 16; ++ct)
#pragma unroll
            for (int e = 0; e < 4; ++e) { const float pv = __expf(st[ct][e] - mx); st[ct][e] = pv; sm += pv; }
        sm += __shfl_xor(sm, 16); sm += __shfl_xor(sm, 32);
        f32x4 ot[8];
#pragma unroll
        for (int dt = 0; dt < 8; ++dt) ot[dt] = (f32x4){0.f, 0.f, 0.f, 0.f};
#pragma unroll
        for (int ks = 0; ks < 8; ++ks) { v4u pw; pw.x = pk2(st[2 * ks][0], st[2 * ks][1]); pw.y = pk2(st[2 * ks][2], st[2 * ks][3]); pw.z = pk2(st[2 * ks + 1][0], st[2 * ks + 1][1]); pw.w = pk2(st[2 * ks + 1][2], st[2 * ks + 1][3]);
            const bf16x8 pb = __builtin_bit_cast(bf16x8, pw);
#pragma unroll
            for (int dt = 0; dt < 8; ++dt) { const LAS unsigned char* vr = lds + MA_VT + (32 * ks + 4 * fq + (fr >> 2)) * 288 + (16 * dt + 4 * (fr & 3)) * 2;
                const v4i16_t lo = vtr(vr), hi = vtr(vr + 16 * 288);
                ot[dt] = MFMA16(__builtin_shufflevector(lo, hi, 0, 1, 2, 3, 4, 5, 6, 7), pb, ot[dt]); } }
        { const size_t m = (size_t)(m0 + 16 * w + fr); const float inv = 1.f / sm;
#pragma unroll
          for (int dt = 0; dt < 8; ++dt) { unsigned long long wv = (unsigned long long)pk2(ot[dt][0] * inv, ot[dt][1] * inv) | ((unsigned long long)pk2(ot[dt][2] * inv, ot[dt][3] * inv) << 32);
              *(unsigned long long*)(QM + m * 512 + h * 128 + 16 * dt + 4 * fq) = wv; } }
    }
    __syncthreads();
}

constexpr int LCH = 128, NCH = T / LCH;
constexpr int LR_XR = 0, LR_WG = 18944, LR_CW = LR_WG + 36864, LR_CB = LR_CW + 1024, LR_GC = LR_CB + 256, LR_SEG = LR_GC + 1536, LR_HB = LR_SEG + 8192, LR_END = LR_HB + 65536;
static_assert(LR_END <= LDS_BYTES - 64, "LRU LDS map");
constexpr size_t WS_C8 = 65536, WS_STATS = 262144; static_assert(WS_STATS == 262144, "EpiResid hard-codes the stats offset");
__device__ __forceinline__ float em1_small(float x) {
    float q = 1.f + x * (1.f / 7.f); q = 1.f + x * (1.f / 6.f) * q; q = 1.f + x * 0.2f * q; q = 1.f + x * 0.25f * q; q = 1.f + x * (1.f / 3.f) * q; q = 1.f + x * 0.5f * q; return x * q;
}
__device__ __forceinline__ void lru_setup(const Params& p, int L, LAS unsigned char* lds, int jb, const int tid) {
    const bf16* WL = (const bf16*)(p.ws + WS_WT) + WT_LRU;
#pragma unroll
    for (int k = 0; k < 4; ++k) { const int c = k * NTHR + tid, row = c >> 3, d8 = c & 7, dir = row >> 7, g = (row >> 6) & 1, o = row & 63;
        *(LAS v4u*)(lds + LR_WG + row * 144 + d8 * 16) = *(const v4u*)(WL + (size_t)((dir * 12 + jb) * 2 + g) * 4096 + o * 64 + d8 * 8); }
    if (tid < 256) ((LAS float*)(lds + LR_CW))[tid] = p.conv_w[(size_t)L * 4 * 768 + (tid >> 6) * 768 + jb * 64 + (tid & 63)];
    if (tid < 64) ((LAS float*)(lds + LR_CB))[tid] = p.conv_b[(size_t)L * 768 + jb * 64 + tid];
    if (tid < 384) { const int dir = tid / 192, q = (tid % 192) >> 6, ch = tid & 63; const size_t gi = (size_t)(L * 2 + dir) * 768 + jb * 64 + ch;
        ((LAS float*)(lds + LR_GC))[tid] = q == 0 ? p.lru_ba[gi] : (q == 1 ? p.lru_bx[gi] : ((const float*)(p.ws + WS_C8))[dir * 768 + jb * 64 + ch]); }
    __syncthreads();
}
__device__ __forceinline__ void lru_load(const Params& p, int ci, int jb, const int tid, v4u (&xv)[3]) {
    const int t0 = ci * LCH;
    int cs, S;
    if (ci < 128) { cs = ci & 63; S = 8192; } else { cs = (ci - 128) & 15; S = 2048; }
    const bf16* QKVX = (const bf16*)(p.ws + WS_QKVX);
#pragma unroll
    for (int k = 0; k < 3; ++k) { const int c = k * NTHR + tid, rr = c >> 3, d8 = c & 7, sq = cs * LCH + rr - 1; xv[k] = (v4u){0u, 0u, 0u, 0u};
        if (c < 131 * 8 && sq >= 0 && sq < S) xv[k] = *(const v4u*)(QKVX + (size_t)(t0 + rr - 1) * 3072 + 2304 + jb * 64 + d8 * 8); }
}
template <bool PHASE_B>
__device__ __forceinline__ void lru_item(const Params& p, LAS unsigned char* lds, int ci, int ci_next, int jb, const int tid, v4u (&xvn)[3]) {
    const int lane = tid & 63, rt = tid >> 6, fr = lane & 15, fq = lane >> 4;
    const int t0 = ci * LCH;
#pragma unroll
    for (int k = 0; k < 3; ++k) { const int c = k * NTHR + tid, rr = c >> 3, d8 = c & 7; if (c < 131 * 8) *(LAS v4u*)(lds + LR_XR + rr * 144 + d8 * 16) = xvn[k]; }
    float cin[2][4]; v4u gv[2];
    __syncthreads();
    if (ci_next >= 0) lru_load(p, ci_next, jb, tid, xvn);
    const LAS float* CW = (const LAS float*)(lds + LR_CW); const LAS float* CB = (const LAS float*)(lds + LR_CB); const LAS float* GC = (const LAS float*)(lds + LR_GC);
    bf16x8 af[2];
#pragma unroll
    for (int ks = 0; ks < 2; ++ks) { const int cb0 = 32 * ks + 8 * fq;
        f32x4 s0 = *(const LAS f32x4*)(CB + cb0), s1 = *(const LAS f32x4*)(CB + cb0 + 4);
#pragma unroll
        for (int tap = 0; tap < 4; ++tap) { const v4u v = *(const LAS v4u*)(lds + LR_XR + (16 * rt + fr + tap) * 144 + cb0 * 2);
            const f32x4 w0 = *(const LAS f32x4*)(CW + tap * 64 + cb0), w1 = *(const LAS f32x4*)(CW + tap * 64 + cb0 + 4);
            s0 += (f32x4){bflo(v.x), bfhi(v.x), bflo(v.y), bfhi(v.y)} * w0; s1 += (f32x4){bflo(v.z), bfhi(v.z), bflo(v.w), bfhi(v.w)} * w1; }
        v4u o; o.x = pk2(s0[0], s0[1]); o.y = pk2(s0[2], s0[3]); o.z = pk2(s1[0], s1[1]); o.w = pk2(s1[2], s1[3]);
        af[ks] = __builtin_bit_cast(bf16x8, o); }
    float xc[4][4];
#pragma unroll
    for (int ct = 0; ct < 4; ++ct) { const int ch = 16 * ct + fr; float xr7[7];
#pragma unroll
        for (int j = 0; j < 7; ++j) xr7[j] = __builtin_bit_cast(float, (unsigned)(*(const LAS bf16*)(lds + LR_XR + (16 * rt + 4 * fq + j) * 144 + ch * 2)) << 16);
        const float w0 = CW[ch], w1 = CW[64 + ch], w2 = CW[128 + ch], w3 = CW[192 + ch], b = CB[ch];
#pragma unroll
        for (int e = 0; e < 4; ++e) xc[ct][e] = b + xr7[e] * w0 + xr7[e + 1] * w1 + xr7[e + 2] * w2 + xr7[e + 3] * w3; }
    float av[2][4][4], uv[2][4][4], pA[2][4], pH[2][4];
#pragma unroll
    for (int dir = 0; dir < 2; ++dir) {
#pragma unroll
        for (int ct = 0; ct < 4; ++ct) {
            f32x4 ga = (f32x4){0.f, 0.f, 0.f, 0.f}, gx = (f32x4){0.f, 0.f, 0.f, 0.f};
#pragma unroll
            for (int ks = 0; ks < 2; ++ks) {
                const bf16x8 wa = *(const LAS bf16x8*)(lds + LR_WG + ((dir * 2 + 0) * 64 + 16 * ct + fr) * 144 + (32 * ks + 8 * fq) * 2);
                const bf16x8 wx = *(const LAS bf16x8*)(lds + LR_WG + ((dir * 2 + 1) * 64 + 16 * ct + fr) * 144 + (32 * ks + 8 * fq) * 2);
                ga = MFMA16(af[ks], wa, ga); gx = MFMA16(af[ks], wx, gx); }
            const int ch = 16 * ct + fr; const float bav = GC[(dir * 3 + 0) * 64 + ch], bxv = GC[(dir * 3 + 1) * 64 + ch], c8 = GC[(dir * 3 + 2) * 64 + ch];
            float Al = 1.f, Hl = 0.f;
#pragma unroll
            for (int ee = 0; ee < 4; ++ee) { const int e = dir ? 3 - ee : ee;
                const float r = __builtin_amdgcn_rcpf(1.f + __expf(-(ga[e] + bav))), ig = __builtin_amdgcn_rcpf(1.f + __expf(-(gx[e] + bxv)));
                const float la = -c8 * r; const float a = __expf(la); const float u = __builtin_amdgcn_sqrtf((1.f - a) * (1.f + a)) * (ig * xc[ct][e]);
                av[dir][ct][e] = a; uv[dir][ct][e] = u; Hl = a * Hl + u; Al *= a; }
            const int o = dir ? 3 - fq : fq; const bool odd = (o & 1) != 0, hi2 = (o & 2) != 0;
            const float A1 = __shfl_xor(Al, 16), H1 = __shfl_xor(Hl, 16);
            const float pxA = odd ? A1 : 1.f, pxH = odd ? H1 : 0.f;
            const float gA = Al * A1, gH = odd ? (Al * H1 + Hl) : (A1 * Hl + H1);
            const float A2 = __shfl_xor(gA, 32), H2 = __shfl_xor(gH, 32);
            const float PA = hi2 ? pxA * A2 : pxA, PH = hi2 ? (pxA * H2 + pxH) : pxH;
            const float TA = gA * A2, TH = hi2 ? (gA * H2 + gH) : (A2 * gH + H2);
            pA[dir][ct] = PA; pH[dir][ct] = PH;
            ((LAS f32x2*)(lds + LR_SEG))[(dir * 8 + rt) * 64 + ch] = (f32x2){TA, TH};
        }
    }
    if constexpr (PHASE_B) {
#pragma unroll
        for (int dir = 0; dir < 2; ++dir)
#pragma unroll
            for (int ct = 0; ct < 4; ++ct) cin[dir][ct] = ((const float*)(p.ws + WS_CIN))[(size_t)(ci * 2 + dir) * 768 + jb * 64 + 16 * ct + fr];
        const bf16* gp = (const bf16*)(p.ws + WS_GR) + (size_t)(t0 + (tid >> 2)) * 768 + jb * 64 + (tid & 3) * 16;
        gv[0] = *(const v4u*)gp; gv[1] = *(const v4u*)(gp + 8);
    }
    __syncthreads();
    if constexpr (!PHASE_B) {
        if (tid < 128) { const int dir = tid >> 6, ch = tid & 63; float A = 1.f, H = 0.f;
#pragma unroll
            for (int q = 0; q < 8; ++q) { const f32x2 sh = ((const LAS f32x2*)(lds + LR_SEG))[(dir * 8 + (dir ? 7 - q : q)) * 64 + ch]; H = sh.x * H + sh.y; A *= sh.x; }
            ((f32x2*)(p.ws + WS_CAR))[(size_t)(ci * 2 + dir) * 768 + jb * 64 + ch] = (f32x2){A, H}; }
    } else {
#pragma unroll
        for (int dir = 0; dir < 2; ++dir) { const int ot = dir ? 7 - rt : rt;
#pragma unroll
            for (int ct = 0; ct < 4; ++ct) { const int ch = 16 * ct + fr; float h = cin[dir][ct];
#pragma unroll
                for (int q = 0; q < 7; ++q) { const f32x2 sh = ((const LAS f32x2*)(lds + LR_SEG))[(dir * 8 + (dir ? 7 - q : q)) * 64 + ch]; const float nh = sh.x * h + sh.y; h = (q < ot) ? nh : h; }
                h = pA[dir][ct] * h + pH[dir][ct];
#pragma unroll
                for (int ee = 0; ee < 4; ++ee) { const int e = dir ? 3 - ee : ee; h = av[dir][ct][e] * h + uv[dir][ct][e];
                    ((LAS float*)(lds + LR_HB))[(dir * LCH + 16 * rt + 4 * fq + e) * 64 + ch] = h; } } }
        __syncthreads();
        { const int t = tid >> 2, c0 = (tid & 3) * 16; bf16* gp = (bf16*)(p.ws + WS_GR) + (size_t)(t0 + t) * 768 + jb * 64 + c0;
          const LAS float* H0 = (const LAS float*)(lds + LR_HB) + t * 64 + c0; const LAS float* H1 = H0 + LCH * 64;
#pragma unroll
          for (int hf = 0; hf < 2; ++hf) { const f32x4 a0 = *(const LAS f32x4*)(H0 + 8 * hf), a1 = *(const LAS f32x4*)(H0 + 8 * hf + 4), b0 = *(const LAS f32x4*)(H1 + 8 * hf), b1 = *(const LAS f32x4*)(H1 + 8 * hf + 4);
              const v4u g = gv[hf]; v4u o;
              o.x = pk2(bflo(g.x) * (a0[0] + b0[0]), bfhi(g.x) * (a0[1] + b0[1])); o.y = pk2(bflo(g.y) * (a0[2] + b0[2]), bfhi(g.y) * (a0[3] + b0[3]));
              o.z = pk2(bflo(g.z) * (a1[0] + b1[0]), bfhi(g.z) * (a1[1] + b1[1])); o.w = pk2(bflo(g.w) * (a1[2] + b1[2]), bfhi(g.w) * (a1[3] + b1[3]));
              *(v4u*)(gp + 8 * hf) = o; } }
    }
}

__device__ __forceinline__ void lru_carry(const Params& p, int gt) {
    if (gt >= 10 * 1536) return;
    const int seq = gt / 1536, rem = gt % 1536, dir = rem / 768, ch = rem % 768;
    int c0, nc; if (seq < 2) { c0 = seq * 64; nc = 64; } else { c0 = 128 + (seq - 2) * 16; nc = 16; }
    const f32x2* CAR = (const f32x2*)(p.ws + WS_CAR); float* CIN = (float*)(p.ws + WS_CIN);
    float h = 0.f;
    for (int k = 0; k < nc; k += 8) { f32x2 v[8];
#pragma unroll
        for (int j = 0; j < 8; ++j) { const int c = dir ? c0 + nc - 1 - (k + j) : c0 + k + j; v[j] = CAR[(size_t)(c * 2 + dir) * 768 + ch]; }
#pragma unroll
        for (int j = 0; j < 8; ++j) { const int c = dir ? c0 + nc - 1 - (k + j) : c0 + k + j; CIN[(size_t)(c * 2 + dir) * 768 + ch] = h; h = v[j].x * h + v[j].y; } }
}
__device__ __forceinline__ void attn_merge(const Params& p, int gt, int ngt) {
    const bf16* QKVX = (const bf16*)(p.ws + WS_QKVX); const float* LSE = (const float*)(p.ws + WS_LSE); bf16* AT = (bf16*)(p.ws + WS_ATTN);
    for (int idx = gt; idx < T * 32; idx += ngt) { const int m = idx >> 5, c8 = idx & 31, h = c8 >> 3;
        const float l0 = LSE[(size_t)m * 12 + h], l1 = LSE[(size_t)m * 12 + 4 + h], l2 = LSE[(size_t)m * 12 + 8 + h];
        const float mx = fmaxf(l0, fmaxf(l1, l2)); float w0 = __expf(l0 - mx), w1 = __expf(l1 - mx), w2 = __expf(l2 - mx); const float inv = 1.f / (w0 + w1 + w2); w0 *= inv; w1 *= inv; w2 *= inv;
        const bf16* o = QKVX + (size_t)m * 3072 + c8 * 8;
        const v4u a = *(const v4u*)o, b = *(const v4u*)(o + 256), c = *(const v4u*)(o + 512);
        v4u r;
        r.x = pk2(w0 * bflo(a.x) + w1 * bflo(b.x) + w2 * bflo(c.x), w0 * bfhi(a.x) + w1 * bfhi(b.x) + w2 * bfhi(c.x));
        r.y = pk2(w0 * bflo(a.y) + w1 * bflo(b.y) + w2 * bflo(c.y), w0 * bfhi(a.y) + w1 * bfhi(b.y) + w2 * bfhi(c.y));
        r.z = pk2(w0 * bflo(a.z) + w1 * bflo(b.z) + w2 * bflo(c.z), w0 * bfhi(a.z) + w1 * bfhi(b.z) + w2 * bfhi(c.z));
        r.w = pk2(w0 * bflo(a.w) + w1 * bflo(b.w) + w2 * bflo(c.w), w0 * bfhi(a.w) + w1 * bfhi(b.w) + w2 * bfhi(c.w));
        *(v4u*)(AT + (size_t)m * 256 + c8 * 8) = r; }
}


#define XB_TMO      128
#define XB_XCNT(j)  (256  + 64 * (j))
#define XB_XSUB(j)  (1280 + 64 * (j))
#define XB_XGEN(j)  (2304 + 64 * (j))
#define XB_TOP      3328
#define XB_TOPGEN   3392
#define XCD_BAR_WORDS 3456
#define XB_SPIN_CAP (1u << 18)
__device__ __forceinline__ unsigned xb_ld(unsigned* p)              { return __hip_atomic_load(p, __ATOMIC_RELAXED, __HIP_MEMORY_SCOPE_AGENT); }
__device__ __forceinline__ unsigned xb_add(unsigned* p, unsigned v) { return __hip_atomic_fetch_add(p, v, __ATOMIC_RELAXED, __HIP_MEMORY_SCOPE_AGENT); }
__device__ __forceinline__ unsigned xb_xcc_id() { return (unsigned)__builtin_amdgcn_s_getreg((3 << 11) | 20) & 0xFu; }
#define XB_SPIN(cond, bar) do { unsigned _sp = 0; while (cond) { __builtin_amdgcn_s_sleep(1); \
    if ((++_sp & 255u) == 0u) { if (xb_ld(&(bar)[XB_TMO])) break; if (_sp > XB_SPIN_CAP) { atomicAdd(&(bar)[XB_TMO], 1u); break; } } } } while (0)
struct XcdBarrier { unsigned* bar; unsigned x; volatile LAS unsigned* st; };
__device__ __forceinline__ XcdBarrier xcd_barrier_post(unsigned* bar, volatile LAS unsigned* st) {
    XcdBarrier b; b.bar = bar; b.x = xb_xcc_id(); b.st = st;
    if (threadIdx.x == 0) (void)xb_add(&bar[XB_XCNT(b.x)], 1u);
    return b;
}
__device__ __forceinline__ void xcd_barrier_complete(unsigned* bar, unsigned x, unsigned& nloc, unsigned& nx) {
    const unsigned G = gridDim.x * gridDim.y * gridDim.z;
    unsigned sum, cnt, mine, sp = 0u;
    for (;;) {
        sum = 0u; cnt = 0u; mine = 0u;
#pragma unroll
        for (unsigned j = 0; j < 16; ++j) { const unsigned c = xb_ld(&bar[XB_XCNT(j)]); sum += c; cnt += (c > 0u) ? 1u : 0u; mine = (j == x) ? c : mine; }
        if (sum == G) break;
        __builtin_amdgcn_s_sleep(1);
        if ((++sp & 255u) == 0u) { if (xb_ld(&bar[XB_TMO])) break; if (sp > XB_SPIN_CAP) { atomicAdd(&bar[XB_TMO], 1u); break; } }
    }
    nloc = mine > 0u ? mine : 1u; nx = cnt > 0u ? cnt : 1u;
}
__device__ __forceinline__ void xcd_barrier(const XcdBarrier& b) {
    asm volatile("s_waitcnt vmcnt(0)" ::: "memory");
    __syncthreads();
    if (threadIdx.x == 0) {
        unsigned* bar = b.bar;
        __builtin_amdgcn_s_waitcnt(0);
        unsigned nloc = b.st[0], nx = b.st[1];
        if (nloc == 0u) { xcd_barrier_complete(bar, b.x, nloc, nx); b.st[0] = nloc; b.st[1] = nx; }
        const unsigned old = xb_add(&bar[XB_XSUB(b.x)], 1u);
        const unsigned gen = old / nloc;
        if (old + 1u == (gen + 1u) * nloc) {
            __builtin_amdgcn_fence(__ATOMIC_RELEASE, "agent");
            asm volatile("s_waitcnt vmcnt(0)" ::: "memory");
            const unsigned og = xb_add(&bar[XB_TOP], 1u);
            const unsigned tg = og / nx;
            if (og + 1u == (tg + 1u) * nx) xb_add(&bar[XB_TOPGEN], 1u);
            else XB_SPIN(xb_ld(&bar[XB_TOPGEN]) == tg, bar);
            __builtin_amdgcn_fence(__ATOMIC_ACQUIRE, "agent");
            xb_add(&bar[XB_XGEN(b.x)], 1u);
            asm volatile("s_waitcnt vmcnt(0)" ::: "memory");
        } else {
            XB_SPIN(xb_ld(&bar[XB_XGEN(b.x)]) == gen, bar);
            __builtin_amdgcn_fence(__ATOMIC_ACQUIRE, "agent");
            asm volatile("s_waitcnt vmcnt(0)" ::: "memory");
        }
    }
    __syncthreads();
}
constexpr int MISC_OFF = LDS_BYTES - 64;

constexpr int N_PHASES = 27;
__global__ void __launch_bounds__(NTHR, 2) fwd_kernel(Params p) {
    extern __shared__ __attribute__((aligned(16))) unsigned char lds_raw[];
    LAS unsigned char* lds = (LAS unsigned char*)lds_raw;
#if MEGA
    if (threadIdx.x < 16) ((LAS unsigned*)(lds + MISC_OFF))[threadIdx.x] = 0u;
    __syncthreads();
    const XcdBarrier xbar = xcd_barrier_post((unsigned*)p.ws, (volatile LAS unsigned*)(lds + MISC_OFF));
#endif
    for (int ph = p.ph_lo; ph < p.ph_hi; ++ph) {
#if MEGA
        if (ph == p.ph_lo + 1) cg::this_grid().sync();
        else if (ph > p.ph_lo) xcd_barrier(xbar);
#endif
        int tid_ = threadIdx.x; asm volatile("" : "+v"(tid_));
        int G_ = gridDim.x, bx_ = blockIdx.x; asm volatile("" : "+s"(G_), "+s"(bx_));
        const int tid = tid_, lane = tid & 63, wave = __builtin_amdgcn_readfirstlane(tid >> 6);
        const int G = G_, bx = bx_, gw = bx * NWAVES + wave, ngw = G * NWAVES;
        unsigned char* ws_ = p.ws; asm volatile("" : "+s"(ws_));
        bf16* WT = (bf16*)(ws_ + WS_WT); bf16* XB = (bf16*)(ws_ + WS_XB); bf16* ACT = (bf16*)(ws_ + WS_ACT);
        if (ph == 0) {
            if (PHON(13)) {
            cvt_weights(p, 0, lds, gw, ngw, wave, lane);
            { int m = gw;
              for (; m + 3 * ngw < T; m += 4 * ngw) { f32x4 v[4][4];
#pragma unroll
                  for (int r = 0; r < 4; ++r) { const int mm = m + r * ngw; const f32x4* xr = (const f32x4*)(mm < 16384 ? p.x_prompt + (size_t)mm * D : p.x_sample + (size_t)(mm - 16384) * D) + lane;
#pragma unroll
                      for (int j = 0; j < 4; ++j) v[r][j] = xr[64 * j]; }
#pragma unroll
                  for (int r = 0; r < 4; ++r) { unsigned long long* o8 = (unsigned long long*)(XB + (size_t)(m + r * ngw) * D) + lane;
#pragma unroll
                      for (int j = 0; j < 4; ++j) o8[64 * j] = (unsigned long long)pk2(v[r][j].x, v[r][j].y) | ((unsigned long long)pk2(v[r][j].z, v[r][j].w) << 32); } }
              for (; m < T; m += ngw) cvt_row((m < 16384 ? p.x_prompt + (size_t)m * D : p.x_sample + (size_t)(m - 16384) * D), XB + (size_t)m * D, lane); }
            bf16* MB = (bf16*)(p.ws + WS_MEMB);
            for (int m = gw; m < 2560; m += ngw) cvt_row((m < 512 ? p.mem_prompt + (size_t)m * D : p.mem_sample + (size_t)(m - 512) * D), MB + (size_t)m * D, lane);
            }
            continue;
        }
        const int L = (ph - 1) / 13, k = (ph - 1) % 13;
        if (PHON(0) && (k == 0 || k == 10)) {
            pg8::Gemm g{XB, WT + (k == 0 ? WT_FFIN0 : WT_FFIN1), T, 2 * DFF, D, D}; pg8::StaticOrder S; S.init(T, 2 * DFF, G, bx);
            pg8::EpiSwiglu E{ACT};
            pg8::gemm_phase<pg8::EpiSwiglu, pg8::StaticOrder, true, true>(lds, g, S, E);
        } else if (PHON(1) && (k == 1 || k == 11)) {
            pg8::Gemm g{ACT, WT + (k == 1 ? WT_FFOUT0 : WT_FFOUT1), T, D, DFF, DFF}; pg8::StaticOrder S; S.init(T, D, G, bx);
            const bool first = (L == 0 && k == 1);
            const int lnl = (k == 1) ? (L - 1) * 3 + 2 : L * 3 + 1;
            pg8::EpiResid E{p.x_prompt, p.x_sample - (size_t)16384 * D, (_Float16*)(ws_ + WS_Z16), ALPHA, 0.5f, &p.ln_g, &p.ws, first ? -1 : lnl};
            pg8::gemm_phase<pg8::EpiResid, pg8::StaticOrder, true, true>(lds, g, S, E);
        } else if (PHON(2) && (k == 2 || k == 9 || k == 12)) {
            const int li = (k == 2) ? 0 : (k == 9 ? 1 : 2);
            const float* gg = p.ln_g + (size_t)(L * 3 + li) * D; const float* bb = p.ln_b + (size_t)(L * 3 + li) * D;
            const bool wbf = !(L == 1 && k == 12);
            { int m = gw;
              for (; m + 3 * ngw < T; m += 4 * ngw) ln_rows<4>((const _Float16*)(ws_ + WS_Z16), XB, (float*)(ws_ + WS_STATS), p.out, m, ngw, gg, bb, lane, !wbf);
              for (; m < T; m += ngw) ln_rows<1>((const _Float16*)(ws_ + WS_Z16), XB, (float*)(ws_ + WS_STATS), p.out, m, ngw, gg, bb, lane, !wbf); }
            if (k == 12 && L == 0) { __syncthreads(); cvt_weights(p, 1, lds, gw, ngw, wave, lane); }
        } else if (PHON(3) && k == 3) {
            pg8::Gemm g{XB, WT + WT_WIN, T, 4352, D, D}; pg8::StaticOrder S; S.init(T, 4352, G, bx);
            pg8::EpiWin E{(bf16*)(p.ws + WS_QKVX), (bf16*)(p.ws + WS_GR), (bf16*)(p.ws + WS_QM)};
            pg8::gemm_phase<pg8::EpiWin, pg8::StaticOrder, true, true>(lds, g, S, E);
            if (bx >= 128) {
                pg8::Gemm g2{(const bf16*)(p.ws + WS_MEMB), WT + WT_MEMKV, 2560, 1024, D, D}; pg8::StaticOrder S2; S2.init(2560, 1024, G, bx - 128);
                pg8::EpiBf16 E2{(bf16*)(p.ws + WS_MEMKV), 1024, 0};
                pg8::gemm_phase<pg8::EpiBf16, pg8::StaticOrder, true, true>(lds, g2, S2, E2);
            }
        } else if (PHON(4) && k == 4) {
            attn_phase(p, lds, bx, G, tid);
            for (int gq = bx; gq < 256; gq += G) memattn_group(p, lds, gq, tid);
            { const int jb = bx % 12, gi = bx / 12, gs = (G - jb + 11) / 12; lru_setup(p, L, lds, jb, tid);
              v4u xvn[3] = {(v4u){0u, 0u, 0u, 0u}, (v4u){0u, 0u, 0u, 0u}, (v4u){0u, 0u, 0u, 0u}};
              if (gi < NCH) lru_load(p, gi, jb, tid, xvn);
              for (int ci = gi; ci < NCH; ci += gs) lru_item<false>(p, lds, ci, (ci + gs < NCH) ? ci + gs : -1, jb, tid, xvn); }
        } else if (PHON(5) && k == 5) {
            lru_carry(p, bx * NTHR + tid);
            attn_merge(p, bx * NTHR + tid, G * NTHR);
        } else if (PHON(6) && k == 6) {
            { const int jb = bx % 12, gi = bx / 12, gs = (G - jb + 11) / 12; lru_setup(p, L, lds, jb, tid);
              v4u xvn[3] = {(v4u){0u, 0u, 0u, 0u}, (v4u){0u, 0u, 0u, 0u}, (v4u){0u, 0u, 0u, 0u}};
              if (gi < NCH) lru_load(p, gi, jb, tid, xvn);
              for (int ci = gi; ci < NCH; ci += gs) lru_item<true>(p, lds, ci, (ci + gs < NCH) ? ci + gs : -1, jb, tid, xvn); }
        } else if (PHON(7) && k == 7) {
            bf16* GB = (bf16*)(p.ws + WS_QKVX);
            { pg8::Gemm g{(const bf16*)(p.ws + WS_ATTN), WT + WT_BRA, T, 1024, 256, 256}; pg8::MgOrder S{G, bx, 0}; pg8::EpiBf16 E{GB, 3072, 0};
              pg8::gemm_phase<pg8::EpiBf16, pg8::MgOrder, true, true>(lds, g, S, E); }
            { pg8::Gemm g{(const bf16*)(p.ws + WS_GR), WT + WT_BRL, T, 1024, 768, 768}; pg8::MgOrder S{G, bx, 1}; pg8::EpiBf16 E{GB, 3072, 1024};
              pg8::gemm_phase<pg8::EpiBf16, pg8::MgOrder, true, true>(lds, g, S, E); }
            { pg8::Gemm g{(const bf16*)(p.ws + WS_QM), WT + WT_BRM, T, 1024, 512, 512}; pg8::MgOrder S{G, bx, 2}; pg8::EpiBf16 E{GB, 3072, 2048};
              pg8::gemm_phase<pg8::EpiBf16, pg8::MgOrder, true, true>(lds, g, S, E); }
            { pg8::Gemm g{XB, WT + WT_WIN + (size_t)4352 * 1024, T, 3072, D, D}; pg8::MgOrder S{G, bx, -1}; pg8::EpiGate E{GB, p.b_gate + (size_t)L * 3072};
              pg8::gemm_phase<pg8::EpiGate, pg8::MgOrder, true, true>(lds, g, S, E); }
        } else if (PHON(8) && k == 8) {
            pg8::Gemm g{(const bf16*)(p.ws + WS_QKVX), WT + WT_WOUT, T, D, D, 3072}; pg8::StaticOrder S; S.init(T, D, G, bx);
            pg8::EpiResid E{p.x_prompt, p.x_sample - (size_t)16384 * D, (_Float16*)(ws_ + WS_Z16), ALPHA, 1.0f, &p.ln_g, &p.ws, L * 3};
            pg8::gemm_phase<pg8::EpiResid, pg8::StaticOrder, true, true>(lds, g, S, E);
        }
    }
}

extern "C" void kernel_launch(void* const* d_in, const int* in_sizes, int n_in, void* d_out, int out_size, void* d_ws, size_t ws_size, hipStream_t stream) {
    static int grid = 0;
    if (grid == 0) {
        if (n_in != 23 || out_size != T * D || ws_size < WS_END) { fprintf(stderr, "kernel_launch: unexpected shapes (n_in %d out %d ws %zu)\n", n_in, out_size, ws_size); grid = -1; return; }
        int dev = 0, cus = 0, per_cu = 0;
        hipGetDevice(&dev); hipDeviceGetAttribute(&cus, hipDeviceAttributeMultiprocessorCount, dev);
        hipFuncSetAttribute((const void*)fwd_kernel, hipFuncAttributeMaxDynamicSharedMemorySize, LDS_BYTES);
        hipOccupancyMaxActiveBlocksPerMultiprocessor(&per_cu, (const void*)fwd_kernel, NTHR, LDS_BYTES);
        (void)hipGetLastError();
        if (per_cu < 1) per_cu = 1;
        grid = cus;
        if (grid > 256) grid = 256;
    }
    if (grid < 0) return;
    Params p{};
    const float** pf = (const float**)&p;
    for (int i = 0; i < 23; ++i) pf[i] = (const float*)d_in[i];
    p.out = (float*)d_out; p.ws = (unsigned char*)d_ws;
#if MEGA
    (void)hipMemsetAsync(d_ws, 0, 16384, stream);
    p.ph_lo = 0; p.ph_hi = N_PHASES;
    void* args[] = {&p};
    hipError_t e = hipLaunchCooperativeKernel((const void*)fwd_kernel, dim3(grid), dim3(NTHR), args, LDS_BYTES, stream);
    if (e != hipSuccess) fprintf(stderr, "cooperative launch failed: %s (grid %d)\n", hipGetErrorString(e), grid);
#else
    for (int ph = 0; ph < N_PHASES; ++ph) { p.ph_lo = ph; p.ph_hi = ph + 1; hipLaunchKernelGGL(fwd_kernel, dim3(grid), dim3(NTHR), LDS_BYTES, stream, p); }
#endif
}
```
